# Optimizing an MI355X kernel written in HIP

```python
import jax, jax.numpy as jnp
from jax import lax
import numpy as np

D_MODEL = 1024
BATCH = 2
SEQ = 8192
DEPTH = 4

N_BRANCH = 4
BRANCH_WIDTH = D_MODEL // N_BRANCH
HEAD_DIM = 64
CONV_WIDTH = BRANCH_WIDTH
CONV_K = 3
RWKV_WIDTH = BRANCH_WIDTH
RWKV_HEADS = RWKV_WIDTH // HEAD_DIM
DECAY_LORA = 64
AAA_LORA = 64
GATE_LORA = 128
RWKV_LN_EPS = 64e-5
MLA_HEADS = BRANCH_WIDTH // HEAD_DIM
QK_NOPE = 64
QK_ROPE = 32
V_HEAD = 64
Q_LORA = 256
KV_LORA = 128
ROPE_THETA = 10000.0
Q_BLOCK = 128
FNET_WIDTH = BRANCH_WIDTH
FNET_GROUPS = FNET_WIDTH // HEAD_DIM
D_FF = -(-8 * D_MODEL // (3 * 256)) * 256
NORM_EPS = 1e-6
IN_SIZES = (CONV_WIDTH, CONV_WIDTH, CONV_WIDTH,
            RWKV_WIDTH, RWKV_WIDTH, RWKV_WIDTH,
            2 * DECAY_LORA, 2 * AAA_LORA, GATE_LORA,
            Q_LORA, KV_LORA + QK_ROPE,
            FNET_WIDTH,
            N_BRANCH * D_MODEL)
IN_WIDTH = sum(IN_SIZES)

kernel_name = "hybrid_conv_rwkv7_mla_fnet_encoder"


def _rmsnorm(x, g, eps=NORM_EPS):
    xf = x.astype(jnp.float32)
    y = xf * lax.rsqrt(jnp.mean(xf * xf, axis=-1, keepdims=True) + eps)
    return (y * g.astype(jnp.float32)).astype(x.dtype)


def _rope(x, cos, sin):
    x1, x2 = jnp.split(x, 2, axis=-1)
    return jnp.concatenate([x1 * cos - x2 * sin, x2 * cos + x1 * sin], axis=-1).astype(x.dtype)


def _short_conv_mixer(u, b, c, conv_w, w_out):
    z = c * u
    zp = jnp.pad(z, ((0, 0), (1, 1), (0, 0)))
    y = zp[:, :-2] * conv_w[0] + zp[:, 1:-1] * conv_w[1] + zp[:, 2:] * conv_w[2]
    return (b * y) @ w_out


def _rwkv7_mixer(r, k, v, w_lo, a_lo, g_lo, mu, w0, w_up, a0, a_up, g_up,
                 k_k, k_a, r_k, ln_g, ln_b, w_out):
    f32 = jnp.float32
    Bn, S, W = r.shape
    H, K = RWKV_HEADS, HEAD_DIM
    prev = lambda t: jnp.pad(t, ((0, 0), (1, 0), (0, 0)))[:, :-1]
    nxt = lambda t: jnp.pad(t, ((0, 0), (0, 1), (0, 0)))[:, 1:]

    def shifted(t, i):
        return jnp.stack([t + mu[0, i] * (prev(t) - t), t + mu[1, i] * (nxt(t) - t)])

    rd, kd, vd = shifted(r, 0), shifted(k, 1), shifted(v, 2)
    w_l = jnp.tanh(w_lo.reshape(Bn, S, 2, DECAY_LORA))
    a_l = a_lo.reshape(Bn, S, 2, AAA_LORA)
    w_log = -jax.nn.softplus(-(w0[:, None, None, :] + jnp.einsum('bsdr,drc->dbsc', w_l, w_up)).astype(f32)) - 0.5
    decay = jnp.exp(-jnp.exp(w_log))
    a = jax.nn.sigmoid((a0[:, None, None, :] + jnp.einsum('bsdr,drc->dbsc', a_l, a_up)).astype(f32))
    g = jax.nn.sigmoid(g_lo) @ g_up
    heads = lambda t: t.astype(f32).reshape(2, Bn, S, H, K)
    rd, kd, vd, decay, a = heads(rd), heads(kd), heads(vd), heads(decay), heads(a)
    kk = kd * k_k.astype(f32).reshape(H, K)
    kk = kk / jnp.maximum(jnp.linalg.norm(kk, axis=-1, keepdims=True), 1e-12)
    kt = kd * (1.0 + (a - 1.0) * k_a.astype(f32).reshape(H, K))

    def to_time(t):
        t = jnp.stack([t[0], jnp.flip(t[1], axis=1)])
        return jnp.moveaxis(t, 2, 0)

    def step(state, inp):
        r_t, w_t, k_t, v_t, kk_t, a_t = inp
        sa = jnp.einsum('dbhvk,dbhk->dbhv', state, kk_t)
        state = (state * w_t[..., None, :] - sa[..., None] * (kk_t * a_t)[..., None, :]
                 + v_t[..., :, None] * k_t[..., None, :])
        return state, jnp.einsum('dbhvk,dbhk->dbhv', state, r_t)

    s0 = jnp.zeros((2, Bn, H, K, K), f32)
    _, ys = lax.scan(step, s0, (to_time(rd), to_time(decay), to_time(kt),
                               to_time(vd), to_time(kk), to_time(a)))
    ys = jnp.moveaxis(ys, 0, 2)
    y = ys[0] + jnp.flip(ys[1], axis=1)
    mean = jnp.mean(y, axis=-1, keepdims=True)
    var = jnp.mean(jnp.square(y - mean), axis=-1, keepdims=True)
    y = (y - mean) * lax.rsqrt(var + RWKV_LN_EPS)
    y = y * ln_g.astype(f32).reshape(H, K) + ln_b.astype(f32).reshape(H, K)
    bonus = jnp.sum(jnp.sum(rd * kt * r_k.astype(f32), axis=-1, keepdims=True) * vd, axis=0)
    out = (y + bonus).reshape(Bn, S, W).astype(r.dtype) * g
    return out @ w_out


def _mla_mixer(q_lo, kv_lo, cos, sin, q_norm, w_uq, kv_norm, w_ukv, w_out):
    Bn, S, _ = q_lo.shape
    H = MLA_HEADS
    q = (_rmsnorm(q_lo, q_norm) @ w_uq).reshape(Bn, S, H, QK_NOPE + QK_ROPE)
    q_nope = q[..., :QK_NOPE]
    q_rope = _rope(q[..., QK_NOPE:], cos[:, :, None, :], sin[:, :, None, :])
    k_rope = _rope(kv_lo[..., KV_LORA:], cos, sin)
    kv = (_rmsnorm(kv_lo[..., :KV_LORA], kv_norm) @ w_ukv).reshape(Bn, S, H, QK_NOPE + V_HEAD)
    k_nope, v = kv[..., :QK_NOPE], kv[..., QK_NOPE:]
    scale = (QK_NOPE + QK_ROPE) ** -0.5
    nblk = S // Q_BLOCK
    blocks = lambda t: jnp.moveaxis(t.reshape(Bn, nblk, Q_BLOCK, H, t.shape[-1]), 1, 0)

    def attend(qb):
        qn, qr = qb
        s = (jnp.einsum('bqhd,bkhd->bhqk', qn, k_nope)
             + jnp.einsum('bqhd,bkd->bhqk', qr, k_rope))
        p = jax.nn.softmax(s.astype(jnp.float32) * scale, axis=-1).astype(v.dtype)
        return jnp.einsum('bhqk,bkhd->bqhd', p, v)

    o = lax.map(attend, (blocks(q_nope), blocks(q_rope)))
    o = jnp.moveaxis(o, 0, 1).reshape(Bn, S, H * V_HEAD)
    return o @ w_out


def _fourier_mixer(u, w_out):
    Bn, S, _ = u.shape
    z = u.reshape(Bn, S, FNET_GROUPS, FNET_WIDTH // FNET_GROUPS).astype(jnp.float32)
    y = jnp.fft.fft2(z, axes=(1, 3), norm="ortho").real
    return y.reshape(Bn, S, FNET_WIDTH).astype(u.dtype) @ w_out


def setup_inputs(seed: int = 0) -> dict:
    key = jax.random.key(seed)
    ks = iter(jax.random.split(key, 40))
    L = DEPTH
    nrm = lambda shape, s: jax.random.normal(next(ks), shape, jnp.float32) * s
    gain = lambda shape: 1.0 + nrm(shape, 0.02)
    x = jax.random.normal(next(ks), (BATCH, SEQ, D_MODEL), jnp.float32)
    positions = (jnp.arange(SEQ, dtype=jnp.int32)[None, :]
                 + jax.random.randint(next(ks), (BATCH, 1), 0, 1024, dtype=jnp.int32))
    return {
        "x": x,
        "positions": positions,
        "mix_norm": gain((L, D_MODEL)),
        "w_in": nrm((L, D_MODEL, IN_WIDTH), D_MODEL ** -0.5),
        "gate_bias": nrm((L, N_BRANCH, D_MODEL), 0.1),
        "conv_w": nrm((L, CONV_K, CONV_WIDTH), CONV_K ** -0.5),
        "conv_out": nrm((L, CONV_WIDTH, D_MODEL), CONV_WIDTH ** -0.5),
        "rwkv_mu": jax.random.uniform(next(ks), (L, 2, 3, RWKV_WIDTH), jnp.float32),
        "rwkv_w0": nrm((L, 2, RWKV_WIDTH), 0.5) - 0.5,
        "rwkv_w_up": nrm((L, 2, DECAY_LORA, RWKV_WIDTH), 0.1),
        "rwkv_a0": nrm((L, 2, RWKV_WIDTH), 0.1),
        "rwkv_a_up": nrm((L, 2, AAA_LORA, RWKV_WIDTH), 0.1),
        "rwkv_g_up": nrm((L, GATE_LORA, RWKV_WIDTH), GATE_LORA ** -0.5),
        "rwkv_k_k": 0.85 + nrm((L, RWKV_WIDTH), 0.05),
        "rwkv_k_a": 1.0 + nrm((L, RWKV_WIDTH), 0.05),
        "rwkv_r_k": nrm((L, RWKV_HEADS, HEAD_DIM), 0.1),
        "rwkv_ln_g": gain((L, RWKV_WIDTH)),
        "rwkv_ln_b": nrm((L, RWKV_WIDTH), 0.02),
        "rwkv_out": nrm((L, RWKV_WIDTH, D_MODEL), RWKV_WIDTH ** -0.5),
        "mla_q_norm": gain((L, Q_LORA)),
        "mla_w_uq": nrm((L, Q_LORA, MLA_HEADS * (QK_NOPE + QK_ROPE)), Q_LORA ** -0.5),
        "mla_kv_norm": gain((L, KV_LORA)),
        "mla_w_ukv": nrm((L, KV_LORA, MLA_HEADS * (QK_NOPE + V_HEAD)), KV_LORA ** -0.5),
        "mla_out": nrm((L, MLA_HEADS * V_HEAD, D_MODEL), (MLA_HEADS * V_HEAD) ** -0.5),
        "fnet_out": nrm((L, FNET_WIDTH, D_MODEL), FNET_WIDTH ** -0.5),
        "w_o": nrm((L, D_MODEL, D_MODEL), D_MODEL ** -0.5),
        "ffn_norm": gain((L, D_MODEL)),
        "ffn_w_gu": nrm((L, D_MODEL, 2 * D_FF), D_MODEL ** -0.5),
        "ffn_w_down": nrm((L, D_FF, D_MODEL), D_FF ** -0.5),
        "final_norm": gain((D_MODEL,)),
    }


def reference(x, positions, mix_norm, w_in, gate_bias, conv_w, conv_out,
              rwkv_mu, rwkv_w0, rwkv_w_up, rwkv_a0, rwkv_a_up, rwkv_g_up,
              rwkv_k_k, rwkv_k_a, rwkv_r_k, rwkv_ln_g, rwkv_ln_b, rwkv_out,
              mla_q_norm, mla_w_uq, mla_kv_norm, mla_w_ukv, mla_out,
              fnet_out, w_o, ffn_norm, ffn_w_gu, ffn_w_down, final_norm):
    Bn, S, D = x.shape
    inv_freq = ROPE_THETA ** (-jnp.arange(0, QK_ROPE, 2, dtype=jnp.float32) / QK_ROPE)
    ang = positions.astype(jnp.float32)[..., None] * inv_freq
    cos, sin = jnp.cos(ang), jnp.sin(ang)
    cuts = [int(c) for c in np.cumsum(IN_SIZES)[:-1]]
    for l in range(DEPTH):
        h = _rmsnorm(x, mix_norm[l])
        (c_x, c_b, c_c, r, k, v, w_lo, a_lo, g_lo,
         q_lo, kv_lo, f_in, gate_logits) = jnp.split(h @ w_in[l], cuts, axis=-1)
        y_a = _short_conv_mixer(c_x, c_b, c_c, conv_w[l], conv_out[l])
        y_b = _rwkv7_mixer(r, k, v, w_lo, a_lo, g_lo, rwkv_mu[l], rwkv_w0[l], rwkv_w_up[l],
                           rwkv_a0[l], rwkv_a_up[l], rwkv_g_up[l], rwkv_k_k[l], rwkv_k_a[l],
                           rwkv_r_k[l], rwkv_ln_g[l], rwkv_ln_b[l], rwkv_out[l])
        y_c = _mla_mixer(q_lo, kv_lo, cos, sin, mla_q_norm[l], mla_w_uq[l],
                         mla_kv_norm[l], mla_w_ukv[l], mla_out[l])
        y_d = _fourier_mixer(f_in, fnet_out[l])
        gates = jax.nn.sigmoid((gate_logits.reshape(Bn, S, N_BRANCH, D) + gate_bias[l])
                               .astype(jnp.float32)).astype(x.dtype)
        branches = jnp.stack([y_a, y_b, y_c, y_d], axis=2)
        x = x + jnp.sum(gates * branches, axis=2) @ w_o[l]
        h2 = _rmsnorm(x, ffn_norm[l])
        gt, up = jnp.split(h2 @ ffn_w_gu[l], 2, axis=-1)
        x = x + (jax.nn.silu(gt) * up) @ ffn_w_down[l]
    return _rmsnorm(x, final_norm)
```

```cpp
#include <hip/hip_runtime.h>
#include <hip/hip_cooperative_groups.h>
#include <cstdio>
#include <cmath>
namespace cg = cooperative_groups;

#define DI __device__ __forceinline__
#ifndef USE_TR
#define USE_TR 1
#endif
#ifndef DUP_MASK
#define DUP_MASK 0
#endif
#ifndef MULTI_LAUNCH
#define MULTI_LAUNCH 0
#endif

typedef __attribute__((address_space(3))) char* lptr;
#define LAS __attribute__((address_space(3)))
typedef short bf16x8 __attribute__((ext_vector_type(8)));
typedef short s16x4 __attribute__((ext_vector_type(4)));
typedef short v4i16_t __attribute__((vector_size(8)));
typedef float f32x16 __attribute__((ext_vector_type(16)));
typedef float f32x4 __attribute__((ext_vector_type(4)));
typedef float f32x2 __attribute__((ext_vector_type(2)));
typedef __bf16 bf16x2_t __attribute__((ext_vector_type(2)));
typedef unsigned u32x4 __attribute__((ext_vector_type(4)));
typedef unsigned u32x2 __attribute__((ext_vector_type(2)));
typedef unsigned short bf16_t;

constexpr int T = 16384, S = 8192, D = 1024, NL = 4, INW = 6688, PW = 2592, DFF = 2816;
constexpr int C_CX = 0, C_CB = 256, C_CC = 512, C_R = 768, C_K = 1024, C_V = 1280, C_WLO = 1536, C_ALO = 1664, C_GLO = 1792,
              C_QLO = 1920, C_KVLO = 2176, C_FIN = 2336, C_GATE = 2592;
constexpr int NTHR = 256;
constexpr int O_WIN = 0, O_CONV = O_WIN + D * INW, O_RWKV = O_CONV + 256 * D, O_MLA = O_RWKV + 256 * D, O_WO = O_MLA + 256 * D,
              O_GU = O_WO + D * D, O_DOWN = O_GU + D * 2 * DFF, O_UQ = O_DOWN + DFF * D, O_UKV = O_UQ + 256 * 384, O_WUP = O_UKV + 128 * 512,
              O_AUP = O_WUP + 2 * 64 * 256, O_GUP = O_AUP + 2 * 64 * 256, WB_ELEMS = O_GUP + 128 * 256;
constexpr int SMEM_BYTES = 57344;

DI unsigned pk2(float a, float b) { f32x2 v = {a, b}; bf16x2_t r = __builtin_convertvector(v, bf16x2_t); return __builtin_bit_cast(unsigned, r); }
DI bf16_t f2bf(float x) { return (bf16_t)(pk2(x, 0.f) & 0xffffu); }
DI float bf2f(bf16_t v) { return __uint_as_float(((unsigned)v) << 16); }
DI float bflo(unsigned u) { return __uint_as_float(u << 16); }
DI float bfhi(unsigned u) { return __uint_as_float(u & 0xffff0000u); }
DI float wave_sum(float x) {
#pragma unroll
  for (int o = 32; o >= 1; o >>= 1) x += __shfl_xor(x, o);
  return x;
}
DI float sigmoidf_(float x) { return __builtin_amdgcn_rcpf(1.f + __expf(-x)); }
DI float tanhf_(float x) { float e = __expf(-2.f * fabsf(x)); float t = (1.f - e) * __builtin_amdgcn_rcpf(1.f + e); return x < 0.f ? -t : t; }
DI s16x4 trr(lptr p) { return __builtin_bit_cast(s16x4, __builtin_amdgcn_ds_read_tr16_b64_v4i16((LAS v4i16_t*)p)); }
DI int otid() { int t = threadIdx.x; asm volatile("" : "+v"(t)); return t; }
DI int crow(int i, int h) { return (i & 3) + 8 * (i >> 2) + 4 * h; }

struct Params {
  const float* x; const int* pos;
  const float *mix_norm, *w_in, *gate_bias, *conv_w, *conv_out, *rwkv_mu, *rwkv_w0, *rwkv_w_up, *rwkv_a0, *rwkv_a_up, *rwkv_g_up,
      *rwkv_k_k, *rwkv_k_a, *rwkv_r_k, *rwkv_ln_g, *rwkv_ln_b, *rwkv_out, *mla_q_norm, *mla_w_uq, *mla_kv_norm, *mla_w_ukv, *mla_out,
      *fnet_out, *w_o, *ffn_norm, *ffn_w_gu, *ffn_w_down, *final_norm;
  float* out;
  float* xres; bf16_t *hb, *mixed, *proj, *preA, *preB, *preC, *Xc, *hidden; bf16_t* fft1; bf16_t* wb;
  bf16_t *Qb, *Kb, *Vt, *LW, *AA, *Gg; float* YS; bf16_t* Wf; float *ropeC, *ropeS; bf16_t *tabC, *tabMS, *tabT2;
  unsigned* bar;
  double invf[16];
};

constexpr int SA_STRIDE = 144;
constexpr int SA_BYTES = 128 * SA_STRIDE;
constexpr int GEMM_SMEM = SA_BYTES + 64 * 320;

template <int ATR> DI unsigned atr2(unsigned u) {
  if (ATR == 0) return u;
  float a = bflo(u), b = bfhi(u);
  if (ATR == 1) { a = tanhf_(a); b = tanhf_(b); }
  if (ATR == 2) { a = sigmoidf_(a); b = sigmoidf_(b); }
  return pk2(a, b);
}

template <int WN, int ATR, int PD = 2>
DI void gemm_acc(f32x16 (&acc)[2][WN], const bf16_t* __restrict__ A, int lda, const bf16_t* __restrict__ B, int ldb, int K, lptr smem) {
  constexpr int BN = 64 * WN, SBS = BN * 2 + 64, CPR = 8 * WN, NB = 2 * WN, RPP = 256 / CPR;
  int tid_ = threadIdx.x; asm volatile("" : "+v"(tid_));
  const int tid = tid_, lane = tid & 63, w = tid >> 6, wm = w >> 1, wn = w & 1;
  const int r = lane & 31, h = lane >> 5;
  const int q = (lane & 15) >> 2, p = lane & 3, blk = (lane >> 4) & 1;
  lptr sA = smem, sB = smem + SA_BYTES;
  u32x4 ra0[4], ra1[4], ra2[4], rb0[NB], rb1[NB], rb2[NB];
  const int nk = K >> 6;
  const unsigned aoff = (unsigned)(((tid >> 3) * lda + (tid & 7) * 8) * 2), astep = (unsigned)(32 * lda * 2);
  const unsigned boff = (unsigned)(((tid / CPR) * ldb + (tid % CPR) * 8) * 2), bstep = (unsigned)(RPP * ldb * 2);
  const unsigned sao = (unsigned)((tid >> 3) * SA_STRIDE + (tid & 7) * 16), sbo = (unsigned)((tid / CPR) * SBS + (tid % CPR) * 16);
  const char* Ac = (const char*)A; const char* Bc = (const char*)B;
  const long bkstep = (long)ldb * 128;
  auto loadt = [&](u32x4 (&ra)[4], u32x4 (&rb)[NB], int kt) {
    const char* a = Ac + kt * 128; const char* b = Bc + kt * bkstep;
#pragma unroll
    for (int i = 0; i < 4; ++i) ra[i] = *(const u32x4*)(a + (aoff + i * astep));
#pragma unroll
    for (int i = 0; i < NB; ++i) rb[i] = *(const u32x4*)(b + (boff + i * bstep));
  };
  auto step = [&](u32x4 (&ra)[4], u32x4 (&rb)[NB], int kt) {
    __syncthreads();
#pragma unroll
    for (int i = 0; i < 4; ++i) {
      u32x4 v = ra[i];
      if (ATR != 0) { v.x = atr2<ATR>(v.x); v.y = atr2<ATR>(v.y); v.z = atr2<ATR>(v.z); v.w = atr2<ATR>(v.w); }
      *(LAS u32x4*)(sA + sao + i * 32 * SA_STRIDE) = v;
    }
#pragma unroll
    for (int i = 0; i < NB; ++i) *(LAS u32x4*)(sB + sbo + i * RPP * SBS) = rb[i];
    __syncthreads();
    loadt(ra, rb, kt + PD < nk ? kt + PD : nk - 1);
    lptr pa = sA + (wm * 64 + r) * SA_STRIDE + 16 * h;
    lptr pb = sB + (8 * h + q) * SBS + (wn * 32 * WN + 16 * blk + 4 * p) * 2;
#pragma unroll
    for (int s = 0; s < 4; ++s) {
      bf16x8 af[2];
#pragma unroll
      for (int mi = 0; mi < 2; ++mi) af[mi] = *(LAS bf16x8*)(pa + mi * 32 * SA_STRIDE + 32 * s);
#pragma unroll
      for (int nj = 0; nj < WN; ++nj) {
        s16x4 lo = trr(pb + 16 * s * SBS + nj * 64), hi = trr(pb + (16 * s + 4) * SBS + nj * 64);
        const bf16x8 bfr = __builtin_shufflevector(lo, hi, 0, 1, 2, 3, 4, 5, 6, 7);
#pragma unroll
        for (int mi = 0; mi < 2; ++mi) acc[mi][nj] = __builtin_amdgcn_mfma_f32_32x32x16_bf16(af[mi], bfr, acc[mi][nj], 0, 0, 0);
      }
    }
  };
  loadt(ra0, rb0, 0);
  __builtin_amdgcn_sched_barrier(0);
  loadt(ra1, rb1, nk > 1 ? 1 : 0);
  __builtin_amdgcn_sched_barrier(0);
  if (PD == 3) { loadt(ra2, rb2, nk > 2 ? 2 : nk - 1); __builtin_amdgcn_sched_barrier(0); }
  if (PD == 3) {
    int kt = 0;
#pragma unroll 1
    for (; kt + 2 < nk; kt += 3) { step(ra0, rb0, kt); step(ra1, rb1, kt + 1); step(ra2, rb2, kt + 2); }
    if (kt < nk) step(ra0, rb0, kt);
    if (kt + 1 < nk) step(ra1, rb1, kt + 1);
  } else {
#pragma unroll 1
    for (int kt = 0; kt < nk; kt += 2) {
      step(ra0, rb0, kt);
      if (kt + 1 < nk) step(ra1, rb1, kt + 1);
    }
  }
}

template <int WN> DI void acc_zero(f32x16 (&acc)[2][WN]) {
#pragma unroll
  for (int mi = 0; mi < 2; ++mi)
#pragma unroll
    for (int nj = 0; nj < WN; ++nj)
#pragma unroll
      for (int i = 0; i < 16; ++i) acc[mi][nj][i] = 0.f;
}
template <int WN, class F> DI void epi_each(F f) {
  int tid_ = threadIdx.x; asm volatile("" : "+v"(tid_));
  const int lane = tid_ & 63, w = tid_ >> 6, wm = w >> 1, wn = w & 1, r = lane & 31, h = lane >> 5;
#pragma unroll
  for (int mi = 0; mi < 2; ++mi)
#pragma unroll
    for (int nj = 0; nj < WN; ++nj)
#pragma unroll
      for (int i = 0; i < 16; ++i) f(mi, nj, i, wm * 64 + mi * 32 + crow(i, h), wn * 32 * WN + nj * 32 + r);
}

constexpr int NG = 16;
DI unsigned bar_ld(unsigned* p) { return __hip_atomic_load(p, __ATOMIC_RELAXED, __HIP_MEMORY_SCOPE_AGENT); }
DI unsigned bar_add(unsigned* p) { return __hip_atomic_fetch_add(p, 1u, __ATOMIC_RELAXED, __HIP_MEMORY_SCOPE_AGENT); }
DI unsigned xcc_id() { return (unsigned)__builtin_amdgcn_s_getreg((3 << 11) | 20) & 0xFu; }
DI void grp_barrier(unsigned* bar, unsigned k, volatile LAS unsigned* st) {
  asm volatile("s_waitcnt vmcnt(0) lgkmcnt(0)" ::: "memory");
  __syncthreads();
  if (threadIdx.x == 0) {
    const unsigned g = xcc_id(), gsize = st[0], ng = st[1];
    const unsigned old = bar_add(bar + 64 * g);
    if (old + 1u == k * gsize) {
      __builtin_amdgcn_fence(__ATOMIC_RELEASE, "agent");
      asm volatile("s_waitcnt vmcnt(0)" ::: "memory");
      (void)bar_add(bar + 64 * (2 * NG));
      while (bar_ld(bar + 64 * (2 * NG)) < k * ng) __builtin_amdgcn_s_sleep(1);
      __builtin_amdgcn_fence(__ATOMIC_ACQUIRE, "agent");
      (void)bar_add(bar + 64 * (NG + g));
      asm volatile("s_waitcnt vmcnt(0)" ::: "memory");
    } else {
      while (bar_ld(bar + 64 * (NG + g)) < k) __builtin_amdgcn_s_sleep(1);
      __builtin_amdgcn_fence(__ATOMIC_ACQUIRE, "agent");
      asm volatile("s_waitcnt vmcnt(0)" ::: "memory");
    }
  }
  __syncthreads();
}

DI void sub_barrier(unsigned* bar, unsigned k, unsigned r, unsigned n) {
  asm volatile("s_waitcnt vmcnt(0) lgkmcnt(0)" ::: "memory");
  __syncthreads();
  if (threadIdx.x == 0) {
    const unsigned g = r % NG, gsize = (n - g + NG - 1) / NG, ng = n < (unsigned)NG ? n : (unsigned)NG;
    __builtin_amdgcn_fence(__ATOMIC_RELEASE, "agent");
    asm volatile("s_waitcnt vmcnt(0)" ::: "memory");
    const unsigned old = bar_add(bar + 64 * g);
    if (old + 1u == k * gsize) {
      (void)bar_add(bar + 64 * (2 * NG));
      while (bar_ld(bar + 64 * (2 * NG)) < k * ng) __builtin_amdgcn_s_sleep(1);
      (void)bar_add(bar + 64 * (NG + g));
    } else {
      while (bar_ld(bar + 64 * (NG + g)) < k) __builtin_amdgcn_s_sleep(1);
    }
    __builtin_amdgcn_fence(__ATOMIC_ACQUIRE, "agent");
    asm volatile("s_waitcnt vmcnt(0)" ::: "memory");
  }
  __syncthreads();
}

struct TileIt { int j, stride, count, base, xmode; };
DI TileIt tile_it(volatile LAS unsigned* xs, int NT, int nb, int bid) {
  TileIt t; const unsigned info = xs ? xs[3] : 0u;
  if (info & 0x100u) { t.xmode = 1; t.j = (int)xs[2]; t.stride = (int)xs[0]; t.count = 16 * NT; t.base = (int)(info & 0xffu) * 16; }
  else { t.xmode = 0; t.j = bid; t.stride = nb; t.count = 128 * NT; t.base = 0; }
  return t;
}
DI void tile_get(const TileIt& t, int NT, int& mt, int& nt) { if (t.xmode) { mt = t.base + (t.j & 15); nt = t.j >> 4; } else { mt = t.j / NT; nt = t.j % NT; } }

template <bool OUTF32>
DI void phase_norm(const float* __restrict__ src, const float* __restrict__ gain, bf16_t* __restrict__ dstb, float* __restrict__ dstf, int nb, int bid) {
  const int tid0 = otid(); const int lane = tid0 & 63, w = tid0 >> 6;
  for (int row = bid * 4 + w; row < T; row += nb * 4) {
    const float* xr = src + (long)row * D;
    f32x4 v[4]; float ss = 0.f;
#pragma unroll
    for (int i = 0; i < 4; ++i) { v[i] = *(const f32x4*)(xr + i * 256 + lane * 4); ss += v[i].x * v[i].x + v[i].y * v[i].y + v[i].z * v[i].z + v[i].w * v[i].w; }
    ss = wave_sum(ss);
    const float rinv = rsqrtf(ss * (1.f / D) + 1e-6f);
#pragma unroll
    for (int i = 0; i < 4; ++i) {
      const f32x4 g = *(const f32x4*)(gain + i * 256 + lane * 4);
      const float a = v[i].x * rinv * g.x, b = v[i].y * rinv * g.y, c = v[i].z * rinv * g.z, d = v[i].w * rinv * g.w;
      if (OUTF32) { f32x4 o = {a, b, c, d}; *(f32x4*)(dstf + (long)row * D + i * 256 + lane * 4) = o; }
      else { u32x2 o; o.x = pk2(a, b); o.y = pk2(c, d); *(u32x2*)(dstb + (long)row * D + i * 256 + lane * 4) = o; }
    }
  }
}

DI void cvt_seg(bf16_t* __restrict__ dst, const float* __restrict__ src, int n, int rowlen, const float* __restrict__ rscale, long gtid, long gn) {
  for (long e = gtid; e < (n >> 2); e += gn) {
    f32x4 v = *(const f32x4*)(src + e * 4);
    if (rscale) { const float sc = rscale[(int)((e * 4) / rowlen)]; v.x *= sc; v.y *= sc; v.z *= sc; v.w *= sc; }
    u32x2 o; o.x = pk2(v.x, v.y); o.y = pk2(v.z, v.w);
    *(u32x2*)(dst + e * 4) = o;
  }
}
DI void phase_cvt_weights(const Params& P, int l, int nb, int bid) {
  const long gtid = (long)bid * NTHR + otid(), gn = (long)nb * NTHR;
  cvt_seg(P.wb + O_WIN, P.w_in + (long)l * D * INW, D * INW, 1, nullptr, gtid, gn);
  cvt_seg(P.wb + O_CONV, P.conv_out + (long)l * 256 * D, 256 * D, 1, nullptr, gtid, gn);
  cvt_seg(P.wb + O_RWKV, P.rwkv_out + (long)l * 256 * D, 256 * D, 1, nullptr, gtid, gn);
  cvt_seg(P.wb + O_MLA, P.mla_out + (long)l * 256 * D, 256 * D, 1, nullptr, gtid, gn);
  cvt_seg(P.wb + O_WO, P.w_o + (long)l * D * D, D * D, 1, nullptr, gtid, gn);
  cvt_seg(P.wb + O_GU, P.ffn_w_gu + (long)l * D * 2 * DFF, D * 2 * DFF, 1, nullptr, gtid, gn);
  cvt_seg(P.wb + O_DOWN, P.ffn_w_down + (long)l * DFF * D, DFF * D, 1, nullptr, gtid, gn);
  cvt_seg(P.wb + O_UQ, P.mla_w_uq + (long)l * 256 * 384, 256 * 384, 384, P.mla_q_norm + l * 256, gtid, gn);
  cvt_seg(P.wb + O_UKV, P.mla_w_ukv + (long)l * 128 * 512, 128 * 512, 512, P.mla_kv_norm + l * 128, gtid, gn);
  cvt_seg(P.wb + O_WUP, P.rwkv_w_up + (long)l * 2 * 64 * 256, 2 * 64 * 256, 1, nullptr, gtid, gn);
  cvt_seg(P.wb + O_AUP, P.rwkv_a_up + (long)l * 2 * 64 * 256, 2 * 64 * 256, 1, nullptr, gtid, gn);
  cvt_seg(P.wb + O_GUP, P.rwkv_g_up + (long)l * 128 * 256, 128 * 256, 1, nullptr, gtid, gn);
}

DI void phase_prologue(const Params& P, int nb, int bid) {
  const long gtid = (long)bid * NTHR + otid(), gn = (long)nb * NTHR;
  for (long e = gtid; e < (long)T * 16; e += gn) {
    const int t = (int)(e >> 4), i = (int)(e & 15);
    const double rev = (double)P.pos[t] * P.invf[i] * 0.15915494309189535;
    const float fr = (float)(rev - floor(rev));
    P.ropeC[e] = __builtin_amdgcn_cosf(fr); P.ropeS[e] = __builtin_amdgcn_sinf(fr);
  }
  for (long e = gtid; e < 128 * 128; e += gn) {
    const int k1 = (int)(e >> 7), n1 = (int)(e & 127);
    const float fr = (float)((k1 * n1) & 127) * (1.f / 128.f);
    P.tabC[e] = f2bf(__builtin_amdgcn_cosf(fr)); P.tabMS[e] = f2bf(-__builtin_amdgcn_sinf(fr));
    const int part = k1 >> 6, k2 = k1 & 63, cpart = n1 >> 6, n2 = n1 & 63;
    const float f2 = (float)((k2 * n2) & 63) * (1.f / 64.f);
    const float c = __builtin_amdgcn_cosf(f2), s = __builtin_amdgcn_sinf(f2);
    float v = (part == 0) ? (cpart == 0 ? c : s) : (cpart == 0 ? -s : c);
    P.tabT2[e] = f2bf(v);
  }
  const float scl = 1.f / sqrtf((float)S * 64.f);
  for (long e = gtid; e < (long)NL * 512 * 1024; e += gn) {
    const int n = (int)(e & 1023), row = (int)((e >> 10) & 511), l = (int)(e >> 19);
    const int part = row >> 8, g = (row >> 6) & 3, c = row & 63;
    const float* wo = P.fnet_out + ((long)l * 256 + g * 64) * 1024 + n;
    float acc = 0.f;
    for (int c2 = 0; c2 < 64; ++c2) {
      const float fr = (float)((c * c2) & 63) * (1.f / 64.f);
      const float tv = part == 0 ? __builtin_amdgcn_cosf(fr) : __builtin_amdgcn_sinf(fr);
      acc += tv * wo[(long)c2 * 1024];
    }
    P.Wf[e] = f2bf(acc * scl);
  }
}

DI void phase_inproj(const Params& P, int l, lptr smem, int nb, int bid, volatile LAS unsigned* xs) {
  for (TileIt it = tile_it(xs, 21, nb, bid); it.j < it.count; it.j += it.stride) {
    int mt, nt; tile_get(it, 21, mt, nt);
    f32x16 acc[2][2]; acc_zero<2>(acc);
    gemm_acc<2, 0, 3>(acc, P.hb + (long)mt * 128 * D, D, P.wb + O_WIN + nt * 128, INW, D, smem);
    epi_each<2>([&](int mi, int nj, int i, int rl, int cl) {
      const int row = mt * 128 + rl, col = nt * 128 + cl; const float v = acc[mi][nj][i];
      if (col < PW) __builtin_nontemporal_store(f2bf(v), &P.proj[(long)row * PW + col]);
    });
  }
}

DI void job_conv(const Params& P, int l, int mt) {
  const float* cw = P.conv_w + (long)l * 3 * 256;
  for (int e = otid(); e < 128 * 256; e += NTHR) {
    const int t = mt * 128 + (e >> 8), c = e & 255, s = t & (S - 1);
    const bf16_t* pr = P.proj + (long)t * PW;
    const float z0 = bf2f(pr[C_CC + c]) * bf2f(pr[C_CX + c]);
    const float zm = s > 0 ? bf2f(pr[C_CC + c - PW]) * bf2f(pr[C_CX + c - PW]) : 0.f;
    const float zp = s < S - 1 ? bf2f(pr[C_CC + c + PW]) * bf2f(pr[C_CX + c + PW]) : 0.f;
    const float y = cw[c] * zm + cw[256 + c] * z0 + cw[512 + c] * zp;
    P.preA[(long)t * 256 + c] = f2bf(bf2f(pr[C_CB + c]) * y);
  }
}

DI void job_mla_prep(const Params& P, int l, int mt, int j, lptr smem) {
  const int tid = otid(), lane = tid & 63, w = tid >> 6;
  LAS float* sR = (LAS float*)(smem + GEMM_SMEM);
  __syncthreads();
  for (int rr = 0; rr < 32; ++rr) {
    const int rl = w * 32 + rr; const bf16_t* pr = P.proj + (long)(mt * 128 + rl) * PW;
    float ss;
    if (j < 3) { const u32x2 u = *(const u32x2*)(pr + C_QLO + lane * 4); const float a = bflo(u.x), b = bfhi(u.x), c = bflo(u.y), d = bfhi(u.y); ss = a * a + b * b + c * c + d * d; }
    else { const unsigned u = *(const unsigned*)(pr + C_KVLO + lane * 2); const float a = bflo(u), b = bfhi(u); ss = a * a + b * b; }
    ss = wave_sum(ss);
    if (lane == 0) sR[rl] = rsqrtf(ss * (j < 3 ? 1.f / 256.f : 1.f / 128.f) + 1e-6f);
  }
  f32x16 acc[2][2]; acc_zero<2>(acc);
  if (j < 3) {
    gemm_acc<2, 0>(acc, P.proj + (long)mt * 128 * PW + C_QLO, PW, P.wb + O_UQ + j * 128, 384, 256, smem);
    const float qs = 0.10206207261596577f * 1.4426950408889634f;
    epi_each<2>([&](int mi, int nj, int i, int rl, int cl) {
      const int t = mt * 128 + rl, col = j * 128 + cl, hh = col / 96, d = col - hh * 96;
      float v = acc[mi][nj][i] * sR[rl] * qs;
      const float pv = __shfl_xor(v, 16);
      if (d >= 64) {
        const float c = P.ropeC[t * 16 + (col & 15)], s = P.ropeS[t * 16 + (col & 15)];
        v = (col & 16) ? (v * c + pv * s) : (v * c - pv * s);
      }
      const int b = t >> 13, sq = t & (S - 1);
      P.Qb[((long)(b * 4 + hh) * S + sq) * 96 + d] = f2bf(v);
    });
  } else {
    const int hh = j - 3;
    gemm_acc<2, 0>(acc, P.proj + (long)mt * 128 * PW + C_KVLO, PW, P.wb + O_UKV + hh * 128, 512, 128, smem);
    const int wn = w & 1, wm = w >> 1, r = lane & 31, h = lane >> 5;
    const int b = (mt * 128) >> 13;
    if (wn == 0) {
      epi_each<2>([&](int mi, int nj, int i, int rl, int cl) {
        const int t = mt * 128 + rl, sq = t & (S - 1);
        P.Kb[((long)(b * 4 + hh) * S + sq) * 96 + cl] = f2bf(acc[mi][nj][i] * sR[rl]);
      });
    } else {
#pragma unroll
      for (int mi = 0; mi < 2; ++mi)
#pragma unroll
        for (int nj = 0; nj < 2; ++nj)
#pragma unroll
          for (int i4 = 0; i4 < 4; ++i4) {
            const int rl = wm * 64 + mi * 32 + 8 * i4 + 4 * h, dv = nj * 32 + r;
            const int sq = (mt * 128 + rl) & (S - 1);
            u32x2 o; o.x = pk2(acc[mi][nj][4 * i4] * sR[rl], acc[mi][nj][4 * i4 + 1] * sR[rl + 1]);
            o.y = pk2(acc[mi][nj][4 * i4 + 2] * sR[rl + 2], acc[mi][nj][4 * i4 + 3] * sR[rl + 3]);
            *(u32x2*)(P.Vt + ((long)(b * 4 + hh) * 64 + dv) * S + sq) = o;
          }
    }
    for (int e = tid; e < 128 * 16; e += NTHR) {
      const int t = mt * 128 + (e >> 4), i = e & 15, sq = t & (S - 1);
      const bf16_t* pr = P.proj + (long)t * PW + C_KVLO + 128;
      const float x1 = bf2f(pr[i]), x2 = bf2f(pr[16 + i]), c = P.ropeC[t * 16 + i], s = P.ropeS[t * 16 + i];
      bf16_t* kd = P.Kb + ((long)(b * 4 + hh) * S + sq) * 96 + 64;
      kd[i] = f2bf(x1 * c - x2 * s); kd[16 + i] = f2bf(x2 * c + x1 * s);
    }
  }
}

DI void job_rwkv_prep(const Params& P, int l, int mt, int which, int nt, lptr smem) {
  f32x16 acc[2][2]; acc_zero<2>(acc);
  const bf16_t* Ab = P.proj + (long)mt * 128 * PW;
  if (which < 2) {
    const int d = which;
    gemm_acc<2, 1>(acc, Ab + C_WLO + d * 64, PW, P.wb + O_WUP + d * 64 * 256 + nt * 128, 256, 64, smem);
    const float* w0 = P.rwkv_w0 + (l * 2 + d) * 256;
    epi_each<2>([&](int mi, int nj, int i, int rl, int cl) {
      const int t = mt * 128 + rl, col = nt * 128 + cl;
      const float z = acc[mi][nj][i] + w0[col];
      const float u = -z; const float sp = fmaxf(u, 0.f) + __logf(1.f + __expf(-fabsf(u)));
      const float wl = -sp - 0.5f;
      P.LW[((long)d * T + t) * 256 + col] = f2bf(-__expf(wl));
    });
  } else if (which < 4) {
    const int d = which - 2;
    gemm_acc<2, 0>(acc, Ab + C_ALO + d * 64, PW, P.wb + O_AUP + d * 64 * 256 + nt * 128, 256, 64, smem);
    const float* a0 = P.rwkv_a0 + (l * 2 + d) * 256;
    epi_each<2>([&](int mi, int nj, int i, int rl, int cl) {
      const int t = mt * 128 + rl, col = nt * 128 + cl;
      P.AA[((long)d * T + t) * 256 + col] = f2bf(sigmoidf_(acc[mi][nj][i] + a0[col]));
    });
  } else {
    gemm_acc<2, 2>(acc, Ab + C_GLO, PW, P.wb + O_GUP + nt * 128, 256, 128, smem);
    epi_each<2>([&](int mi, int nj, int i, int rl, int cl) {
      const int t = mt * 128 + rl, col = nt * 128 + cl;
      P.Gg[(long)t * 256 + col] = f2bf(acc[mi][nj][i]);
    });
  }
}

DI void job_fft1(const Params& P, int b, int n2, int nt, lptr smem) {
  f32x16 are[2][1], aim[2][1]; acc_zero<1>(are); acc_zero<1>(aim);
  const bf16_t* Bp = P.proj + ((long)(b * S + n2)) * PW + C_FIN + nt * 64;
  gemm_acc<1, 0>(are, P.tabC, 128, Bp, 64 * PW, 128, smem);
  gemm_acc<1, 0>(aim, P.tabMS, 128, Bp, 64 * PW, 128, smem);
  epi_each<1>([&](int mi, int nj, int i, int rl, int cl) {
    const int k1 = rl, col = nt * 64 + cl;
    const float fr = (float)((n2 * k1) & 8191) * (1.f / 8192.f);
    const float c = __builtin_amdgcn_cosf(fr), s = __builtin_amdgcn_sinf(fr);
    const float re = are[mi][nj][i], im = aim[mi][nj][i];
    bf16_t* o = P.fft1 + (((long)(b * 128 + k1) * 128) + n2) * 256 + col;
    o[0] = f2bf(re * c + im * s); o[64 * 256] = f2bf(im * c - re * s);
  });
}

DI void phase2(const Params& P, int l, lptr smem, int nb, int bid) {
  for (int job = bid; job < 1280; job += nb) job_rwkv_prep(P, l, job / 10, (job % 10) >> 1, job & 1, smem);
}

#define LDS_SYNC() { asm volatile("s_waitcnt lgkmcnt(0)" ::: "memory"); __syncthreads(); }
DI float dpp_xor1(float x) { return __int_as_float(__builtin_amdgcn_mov_dpp(__float_as_int(x), 0xB1, 0xF, 0xF, true)); }
DI float dpp_xor2(float x) { return __int_as_float(__builtin_amdgcn_mov_dpp(__float_as_int(x), 0x4E, 0xF, 0xF, true)); }

DI float dpp_ror4(float x) { return __int_as_float(__builtin_amdgcn_mov_dpp(__float_as_int(x), 0x124, 0xF, 0xF, true)); }
DI float dpp_ror8(float x) { return __int_as_float(__builtin_amdgcn_mov_dpp(__float_as_int(x), 0x128, 0xF, 0xF, true)); }
DI float row16_sum(float x) { x += dpp_xor1(x); x += dpp_xor2(x); x += dpp_ror4(x); x += dpp_ror8(x); return x; }
DI float rdl(float x, int l) { return __int_as_float(__builtin_amdgcn_readlane(__float_as_int(x), l)); }
DI float wave_sum_fast(float x) { x = row16_sum(x); return (rdl(x, 0) + rdl(x, 16)) + (rdl(x, 32) + rdl(x, 48)); }

struct ScanRaw { bf16_t r[9], k[9], v[9], lw[8], aa[8]; };
constexpr int SCB = 6400;
DI void job_scan(const Params& P, int l, int job, lptr smem) {
  const int chain = job >> 3, v0 = (job & 7) * 8;
  const int d = chain >> 3, b = (chain >> 2) & 1, hh = chain & 3;
  const int tid = otid(), lane = tid & 63, w = tid >> 6;
  LAS float* sbase = (LAS float*)smem;
  if (w >= 2) {
    const int pw = w - 2, ptid = tid - 128;
    const int gc = hh * 64 + lane;
    const float mu_r = P.rwkv_mu[((l * 2 + d) * 3 + 0) * 256 + gc], mu_k = P.rwkv_mu[((l * 2 + d) * 3 + 1) * 256 + gc], mu_v = P.rwkv_mu[((l * 2 + d) * 3 + 2) * 256 + gc];
    const float kkc = P.rwkv_k_k[l * 256 + gc], kac = P.rwkv_k_a[l * 256 + gc];
    ScanRaw raw;
    auto load_raw = [&](int chunk) {
#pragma unroll
      for (int e = 0; e < 9; ++e) {
        const int tau = chunk * 16 + pw * 8 + e - 1;
        const int tc = tau < 0 ? 0 : tau, s = d == 0 ? tc : S - 1 - tc;
        const bf16_t* pr = P.proj + (long)(b * S + s) * PW;
        raw.r[e] = pr[C_R + gc]; raw.k[e] = pr[C_K + gc]; raw.v[e] = pr[C_V + gc];
        if (e > 0) { raw.lw[e - 1] = P.LW[((long)d * T + b * S + s) * 256 + gc]; raw.aa[e - 1] = P.AA[((long)d * T + b * S + s) * 256 + gc]; }
      }
    };
    auto prep = [&](int chunk) {
      LAS float* B = sbase + (chunk & 1) * SCB;
      const bool first = (chunk == 0 && pw == 0);
      float rp = first ? 0.f : bf2f(raw.r[0]), kp = first ? 0.f : bf2f(raw.k[0]), vp = first ? 0.f : bf2f(raw.v[0]);
#pragma unroll
      for (int e = 0; e < 8; ++e) {
        const int i = pw * 8 + e;
        const float r0 = bf2f(raw.r[e + 1]), k0 = bf2f(raw.k[e + 1]), vv0 = bf2f(raw.v[e + 1]);
        const float rd = r0 + mu_r * (rp - r0), kd = k0 + mu_k * (kp - k0), vd = vv0 + mu_v * (vp - vv0);
        rp = r0; kp = k0; vp = vv0;
        const float lw = bf2f(raw.lw[e]), aa = bf2f(raw.aa[e]);
        const float pk_ = kd * kkc, kt = kd * (1.f + (aa - 1.f) * kac);
        const float ss = wave_sum_fast(pk_ * pk_);
        const float inv = __builtin_amdgcn_rsqf(fmaxf(ss, 1e-24f));
        const float kk = pk_ * inv, wd = __expf(lw);
        B[i * 64 + lane] = rd; B[1024 + i * 64 + lane] = wd; B[2048 + i * 64 + lane] = kt;
        B[3072 + i * 64 + lane] = kk; B[4096 + i * 64 + lane] = kk * aa; B[5120 + i * 64 + lane] = vd;
      }
    };
    load_raw(0);
    prep(0);
    load_raw(1);
    for (int c = 0; c <= 512; ++c) {
      LDS_SYNC();
      if (c > 0) {
        const int i = ptid >> 3, cc = ptid & 7;
        const int tau = (c - 1) * 16 + i, s = d == 0 ? tau : S - 1 - tau;
        P.YS[((long)d * T + b * S + s) * 256 + hh * 64 + v0 + cc] = sbase[((c - 1) & 1) * SCB + 6176 + i * 8 + cc];
      }
      if (c < 511) { prep(c + 1); load_raw(c + 2 < 512 ? c + 2 : 511); }
    }
  } else {
    const int vr = w * 4 + (lane >> 4), kq = lane & 15;
    f32x4 st = {0.f, 0.f, 0.f, 0.f};
    for (int c = 0; c <= 512; ++c) {
      LDS_SYNC();
      if (c < 512) {
        LAS float* B = sbase + (c & 1) * SCB;
        LAS float* sRD = B; LAS float* sW = B + 1024; LAS float* sKT = B + 2048; LAS float* sKK = B + 3072; LAS float* sBB = B + 4096; LAS float* sV = B + 5120;
        LAS float* sY = B + 6176;
        f32x4 kk4 = *(LAS f32x4*)(sKK + kq * 4), rd4 = *(LAS f32x4*)(sRD + kq * 4), w4 = *(LAS f32x4*)(sW + kq * 4), b4 = *(LAS f32x4*)(sBB + kq * 4), kt4 = *(LAS f32x4*)(sKT + kq * 4);
        float vv = sV[v0 + vr];
        float ykeep = 0.f;
        float ypend = 0.f;
#pragma unroll
        for (int i = 0; i < 16; ++i) {
          const int in = (i + 1) & 15, o = in * 64 + kq * 4;
          const f32x4 nkk4 = *(LAS f32x4*)(sKK + o), nrd4 = *(LAS f32x4*)(sRD + o), nw4 = *(LAS f32x4*)(sW + o), nb4 = *(LAS f32x4*)(sBB + o), nkt4 = *(LAS f32x4*)(sKT + o);
          const float nvv = sV[in * 64 + v0 + vr];
          float sa = (st.x * kk4.x + st.y * kk4.y) + (st.z * kk4.z + st.w * kk4.w);
          float yp = ypend;
          sa += dpp_xor1(sa); yp += dpp_xor1(yp); sa += dpp_xor2(sa); yp += dpp_xor2(yp);
          sa += dpp_ror4(sa); yp += dpp_ror4(yp); sa += dpp_ror8(sa); yp += dpp_ror8(yp);
          if (i > 0) ykeep = kq == i - 1 ? yp : ykeep;
          st.x = st.x * w4.x - sa * b4.x + vv * kt4.x; st.y = st.y * w4.y - sa * b4.y + vv * kt4.y;
          st.z = st.z * w4.z - sa * b4.z + vv * kt4.z; st.w = st.w * w4.w - sa * b4.w + vv * kt4.w;
          ypend = (st.x * rd4.x + st.y * rd4.y) + (st.z * rd4.z + st.w * rd4.w);
          kk4 = nkk4; rd4 = nrd4; w4 = nw4; b4 = nb4; kt4 = nkt4; vv = nvv;
        }
        { const float yp = row16_sum(ypend); ykeep = kq == 15 ? yp : ykeep; }
        sY[kq * 8 + vr] = ykeep;
      }
    }
  }
}

constexpr int SK_STRIDE = 208, SV_STRIDE = 144;
DI void job_attn(const Params& P, int job, lptr smem) {
  const int bh = job >> 6, qb = job & 63, q0 = qb * 128;
  const int tid = otid(), lane = tid & 63, w = tid >> 6, r = lane & 31, h = lane >> 5;
  lptr sK = smem, sV = smem + 64 * SK_STRIDE;
  const bf16_t* Kg = P.Kb + (long)bh * S * 96; const bf16_t* Vg = P.Vt + (long)bh * 64 * S;
  bf16x8 qf[6];
  { const bf16_t* qp = P.Qb + ((long)bh * S + q0 + w * 32 + r) * 96 + 8 * h;
#pragma unroll
    for (int s = 0; s < 6; ++s) qf[s] = *(const bf16x8*)(qp + 16 * s); }
  f32x16 O[2];
#pragma unroll
  for (int i = 0; i < 16; ++i) { O[0][i] = 0.f; O[1][i] = 0.f; }
  float m = -1e30f, lsum = 0.f;
  u32x4 rk[3], rv[2];
#pragma unroll
  for (int i = 0; i < 3; ++i) { const int c = tid + 256 * i; rk[i] = *(const u32x4*)(Kg + (long)(c / 12) * 96 + (c % 12) * 8); }
#pragma unroll
  for (int i = 0; i < 2; ++i) { const int c = tid + 256 * i; rv[i] = *(const u32x4*)(Vg + (long)(c >> 3) * S + (c & 7) * 8); }
  for (int kt = 0; kt < 128; ++kt) {
    __syncthreads();
#pragma unroll
    for (int i = 0; i < 3; ++i) { const int c = tid + 256 * i; *(LAS u32x4*)(sK + (c / 12) * SK_STRIDE + (c % 12) * 16) = rk[i]; }
#pragma unroll
    for (int i = 0; i < 2; ++i) { const int c = tid + 256 * i; *(LAS u32x4*)(sV + (c >> 3) * SV_STRIDE + (c & 7) * 16) = rv[i]; }
    __syncthreads();
    if (kt + 1 < 128) {
      const int k0 = (kt + 1) * 64;
#pragma unroll
      for (int i = 0; i < 3; ++i) { const int c = tid + 256 * i; rk[i] = *(const u32x4*)(Kg + (long)(k0 + c / 12) * 96 + (c % 12) * 8); }
#pragma unroll
      for (int i = 0; i < 2; ++i) { const int c = tid + 256 * i; rv[i] = *(const u32x4*)(Vg + (long)(c >> 3) * S + k0 + (c & 7) * 8); }
    }
    f32x16 sc[2];
#pragma unroll
    for (int ks = 0; ks < 2; ++ks) {
#pragma unroll
      for (int i = 0; i < 16; ++i) sc[ks][i] = 0.f;
#pragma unroll
      for (int s = 0; s < 6; ++s) {
        const bf16x8 kf = *(LAS bf16x8*)(sK + (ks * 32 + r) * SK_STRIDE + (16 * s + 8 * h) * 2);
        sc[ks] = __builtin_amdgcn_mfma_f32_32x32x16_bf16(kf, qf[s], sc[ks], 0, 0, 0);
      }
    }
    float mx = sc[0][0];
#pragma unroll
    for (int i = 0; i < 16; ++i) { mx = fmaxf(mx, sc[0][i]); mx = fmaxf(mx, sc[1][i]); }
    mx = fmaxf(mx, __shfl_xor(mx, 32));
    const float mn = fmaxf(m, mx), alpha = __builtin_amdgcn_exp2f(m - mn);
    m = mn;
    float rs = 0.f;
#pragma unroll
    for (int ks = 0; ks < 2; ++ks)
#pragma unroll
      for (int i = 0; i < 16; ++i) { const float pe = __builtin_amdgcn_exp2f(sc[ks][i] - mn); sc[ks][i] = pe; rs += pe; }
    lsum = lsum * alpha + rs;
#pragma unroll
    for (int i = 0; i < 16; ++i) { O[0][i] *= alpha; O[1][i] *= alpha; }
#pragma unroll
    for (int ks = 0; ks < 2; ++ks)
#pragma unroll
      for (int s2 = 0; s2 < 2; ++s2) {
        u32x4 pw; pw.x = pk2(sc[ks][8 * s2], sc[ks][8 * s2 + 1]); pw.y = pk2(sc[ks][8 * s2 + 2], sc[ks][8 * s2 + 3]);
        pw.z = pk2(sc[ks][8 * s2 + 4], sc[ks][8 * s2 + 5]); pw.w = pk2(sc[ks][8 * s2 + 6], sc[ks][8 * s2 + 7]);
        const bf16x8 pf = __builtin_bit_cast(bf16x8, pw);
        const int kb = ks * 32 + 16 * s2;
#pragma unroll
        for (int dvt = 0; dvt < 2; ++dvt) {
          lptr vp = sV + (dvt * 32 + r) * SV_STRIDE + (kb + 4 * h) * 2;
          const s16x4 lo = *(LAS s16x4*)vp, hi = *(LAS s16x4*)(vp + 16);
          const bf16x8 vf = __builtin_shufflevector(lo, hi, 0, 1, 2, 3, 4, 5, 6, 7);
          O[dvt] = __builtin_amdgcn_mfma_f32_32x32x16_bf16(vf, pf, O[dvt], 0, 0, 0);
        }
      }
  }
  lsum += __shfl_xor(lsum, 32);
  const float inv = 1.f / lsum;
  const int b = bh >> 2, hh = bh & 3;
  bf16_t* op = P.preC + ((long)(b * S + q0 + w * 32 + r)) * 256 + hh * 64;
#pragma unroll
  for (int dvt = 0; dvt < 2; ++dvt)
#pragma unroll
    for (int i4 = 0; i4 < 4; ++i4) {
      u32x2 o; o.x = pk2(O[dvt][4 * i4] * inv, O[dvt][4 * i4 + 1] * inv); o.y = pk2(O[dvt][4 * i4 + 2] * inv, O[dvt][4 * i4 + 3] * inv);
      *(u32x2*)(op + dvt * 32 + 8 * i4 + 4 * h) = o;
    }
}

DI void job_fft2(const Params& P, int b, int k1, int nt, lptr smem) {
  f32x16 acc[2][2]; acc_zero<2>(acc);
  gemm_acc<2, 0>(acc, P.tabT2, 128, P.fft1 + ((long)(b * 128 + k1) * 128) * 256 + nt * 128, 256, 128, smem);
  epi_each<2>([&](int mi, int nj, int i, int rl, int cl) {
    const int part = rl >> 6, k2 = rl & 63, s = k1 + 128 * k2;
    P.Xc[((long)(b * S + s)) * 512 + part * 256 + nt * 128 + cl] = f2bf(acc[mi][nj][i]);
  });
}

template <int MASK> DI void phase5(const Params& P, int l, lptr smem, int nb, int bid, volatile LAS unsigned* xs, unsigned* dynctr);
DI void phase3(const Params& P, int l, lptr smem, int nb, int bid) {
  if (bid < 128) { __builtin_amdgcn_s_setprio(3); job_scan(P, l, bid, smem); __builtin_amdgcn_s_setprio(0); return; }
  const int r = bid - 128, n = nb - 128;
  for (int job = r; job < 128 + 896 + 512; job += n) {
    if (job < 128) job_conv(P, l, job);
    else if (job < 1024) { const int e = job - 128; job_mla_prep(P, l, e / 7, e % 7, smem); }
    else { const int e = job - 1024; job_fft1(P, e >> 8, (e >> 2) & 63, e & 3, smem); }
  }
  sub_barrier(P.bar + 64 * (3 * NG + 1), (unsigned)(2 * l + 1), (unsigned)r, (unsigned)n);
  for (int job = r; job < 512 + 512; job += n) {
    if (job < 512) job_attn(P, job, smem);
    else { const int e = job - 512; job_fft2(P, e >> 8, (e >> 1) & 127, e & 1, smem); }
  }
  phase5<1>(P, l, smem, n, r, nullptr, P.bar + 64 * (5 * NG + 2) + l);
  sub_barrier(P.bar + 64 * (3 * NG + 1), (unsigned)(2 * l + 2), (unsigned)r, (unsigned)n);
  phase5<4 | 8>(P, l, smem, n, r, nullptr, nullptr);
}

DI void phase4(const Params& P, int l, int nb, int bid) {
  const int tid0 = otid(); const int lane = tid0 & 63, hh = tid0 >> 6, gc = hh * 64 + lane;
  const float lng = P.rwkv_ln_g[l * 256 + gc], lnb = P.rwkv_ln_b[l * 256 + gc], rk = P.rwkv_r_k[l * 256 + gc], kac = P.rwkv_k_a[l * 256 + gc];
  float mu[2][3];
#pragma unroll
  for (int d = 0; d < 2; ++d)
#pragma unroll
    for (int i = 0; i < 3; ++i) mu[d][i] = P.rwkv_mu[((l * 2 + d) * 3 + i) * 256 + gc];
  for (int t = bid; t < T; t += nb) {
    const int s = t & (S - 1);
    const float y = P.YS[(long)t * 256 + gc] + P.YS[((long)T + t) * 256 + gc];
    const float mean = wave_sum_fast(y) * (1.f / 64.f); const float dy = y - mean;
    const float var = wave_sum_fast(dy * dy) * (1.f / 64.f);
    const float yn = dy * rsqrtf(var + 64e-5f) * lng + lnb;
    const bf16_t* pr = P.proj + (long)t * PW;
    const float r0 = bf2f(pr[C_R + gc]), k0 = bf2f(pr[C_K + gc]), v0 = bf2f(pr[C_V + gc]);
    float bonus = 0.f;
#pragma unroll
    for (int d = 0; d < 2; ++d) {
      const bool valid = d == 0 ? (s > 0) : (s < S - 1);
      const bf16_t* pn = d == 0 ? pr - PW : pr + PW;
      const float rn = valid ? bf2f(pn[C_R + gc]) : 0.f, kn = valid ? bf2f(pn[C_K + gc]) : 0.f, vn = valid ? bf2f(pn[C_V + gc]) : 0.f;
      const float rd = r0 + mu[d][0] * (rn - r0), kd = k0 + mu[d][1] * (kn - k0), vd = v0 + mu[d][2] * (vn - v0);
      const float aa = bf2f(P.AA[((long)d * T + t) * 256 + gc]);
      const float kt = kd * (1.f + (aa - 1.f) * kac);
      bonus += wave_sum_fast(rd * kt * rk) * vd;
    }
    P.preB[(long)t * 256 + gc] = f2bf((yn + bonus) * bf2f(P.Gg[(long)t * 256 + gc]));
  }
}

template <int MASK>
DI void phase5(const Params& P, int l, lptr smem, int nb, int bid, volatile LAS unsigned* xs, unsigned* dynctr) {
  LAS int* sj = (LAS int*)(smem + 40960);
  TileIt it = tile_it(xs, 8, nb, bid);
  for (;;) {
    int mt, nt;
    if (dynctr) {
      __syncthreads();
      if (threadIdx.x == 0) *sj = (int)__hip_atomic_fetch_add(dynctr, 1u, __ATOMIC_RELAXED, __HIP_MEMORY_SCOPE_AGENT);
      __syncthreads();
      const int tile = *sj; if (tile >= 1024) break;
      mt = tile >> 3; nt = tile & 7;
    } else {
      if (it.j >= it.count) break;
      tile_get(it, 8, mt, nt); it.j += it.stride;
    }
    auto branch = [&](int j, const bf16_t* pre, int Kj, const bf16_t* Wout) {
      f32x16 g[2][2]; acc_zero<2>(g);
      gemm_acc<2, 0>(g, P.hb + (long)mt * 128 * D, D, P.wb + O_WIN + C_GATE + j * 1024 + nt * 128, INW, D, smem);
      f32x16 y[2][2]; acc_zero<2>(y);
      gemm_acc<2, 0>(y, pre + (long)mt * 128 * Kj, Kj, Wout + nt * 128, 1024, Kj, smem);
      const float* bias = P.gate_bias + ((long)l * 4 + j) * 1024 + nt * 128;
      epi_each<2>([&](int mi, int nj, int i, int rl, int cl) {
        bf16_t* o = P.mixed + (unsigned)((mt * 128 + rl) * D + nt * 128 + cl);
        float v = sigmoidf_(g[mi][nj][i] + bias[cl]) * y[mi][nj][i];
        if (j > 0) v += bf2f(*o);
        *o = f2bf(v);
      });
    };
    if (MASK & 1) branch(0, P.preA, 256, P.wb + O_CONV);
    if (MASK & 2) branch(1, P.preB, 256, P.wb + O_RWKV);
    if (MASK & 4) branch(2, P.preC, 256, P.wb + O_MLA);
    if (MASK & 8) branch(3, P.Xc, 512, P.Wf + (long)l * 512 * 1024);
  }
}

DI void phase_resid_gemm(const Params& P, const bf16_t* A, int K, const bf16_t* W, const float* xsrc, lptr smem, int nb, int bid, volatile LAS unsigned* xs) {
  for (TileIt it = tile_it(xs, 8, nb, bid); it.j < it.count; it.j += it.stride) {
    int mt, nt; tile_get(it, 8, mt, nt);
    f32x16 acc[2][2]; acc_zero<2>(acc);
    gemm_acc<2, 0, 3>(acc, A + (long)mt * 128 * K, K, W + nt * 128, D, K, smem);
    epi_each<2>([&](int mi, int nj, int i, int rl, int cl) {
      const long o = (long)(mt * 128 + rl) * D + nt * 128 + cl;
      P.xres[o] = xsrc[o] + acc[mi][nj][i];
    });
  }
}

DI void phase_ffn_gu(const Params& P, int l, lptr smem, int nb, int bid, volatile LAS unsigned* xs) {
  const bf16_t* W = P.wb + O_GU;
  for (TileIt it = tile_it(xs, 22, nb, bid); it.j < it.count; it.j += it.stride) {
    int mt, nt; tile_get(it, 22, mt, nt);
    f32x16 g[2][2], u[2][2]; acc_zero<2>(g); acc_zero<2>(u);
    gemm_acc<2, 0>(g, P.hb + (long)mt * 128 * D, D, W + nt * 128, 2 * DFF, D, smem);
    gemm_acc<2, 0>(u, P.hb + (long)mt * 128 * D, D, W + DFF + nt * 128, 2 * DFF, D, smem);
    epi_each<2>([&](int mi, int nj, int i, int rl, int cl) {
      const float gv = g[mi][nj][i];
      __builtin_nontemporal_store(f2bf(gv * sigmoidf_(gv) * u[mi][nj][i]), &P.hidden[(long)(mt * 128 + rl) * DFF + nt * 128 + cl]);
    });
  }
}

template <int PH> DI void run_phase(const Params& P, int l, lptr smem, int nb, int bid, volatile LAS unsigned* xs) {
  if (PH == 0) { phase_prologue(P, nb, bid); }
  if (PH == 1) { phase_norm<false>(l == 0 ? P.x : P.xres, P.mix_norm + l * D, P.hb, nullptr, nb, bid); phase_cvt_weights(P, l, nb, bid); }
  if (PH == 2) phase_inproj(P, l, smem, nb, bid, xs);
  if (PH == 3) phase2(P, l, smem, nb, bid);
  if (PH == 4) phase3(P, l, smem, nb, bid);
  if (PH == 5) phase4(P, l, nb, bid);
  if (PH == 6) phase5<2>(P, l, smem, nb, bid, xs, nullptr);
  if (PH == 7) phase_resid_gemm(P, P.mixed, D, P.wb + O_WO, l == 0 ? P.x : P.xres, smem, nb, bid, xs);
  if (PH == 8) phase_norm<false>(P.xres, P.ffn_norm + l * D, P.hb, nullptr, nb, bid);
  if (PH == 9) phase_ffn_gu(P, l, smem, nb, bid, xs);
  if (PH == 10) phase_resid_gemm(P, P.hidden, DFF, P.wb + O_DOWN, P.xres, smem, nb, bid, xs);
  if (PH == 11) phase_norm<true>(P.xres, P.final_norm, nullptr, P.out, nb, bid);
}

#if !MULTI_LAUNCH
__global__ void __launch_bounds__(NTHR, 2) mega_kernel(Params P) {
  __shared__ __attribute__((aligned(16))) char smem_raw[SMEM_BYTES];
  lptr smem = (lptr)smem_raw;
  cg::grid_group grid = cg::this_grid();
  const int nb = gridDim.x, bid = blockIdx.x;
  unsigned bar_target = 0;
  __shared__ uint4 xb_words;
  volatile LAS unsigned* xst = (volatile LAS unsigned*)&xb_words;
  if (threadIdx.x == 0) xst[2] = bar_add(P.bar + 64 * (2 * NG + 1 + xcc_id()));
  run_phase<0>(P, 0, smem, nb, bid, xst);
  grid.sync();
  if (threadIdx.x == 0) {
    unsigned mine = 0, cnt = 0, dense = 0; const unsigned me = xcc_id();
    for (unsigned j = 0; j < 16; ++j) { const unsigned c = bar_ld(P.bar + 64 * (2 * NG + 1 + j)); cnt += c > 0u ? 1u : 0u; dense += (j < me && c > 0u) ? 1u : 0u; mine = j == me ? c : mine; }
    xst[0] = mine; xst[1] = cnt; xst[3] = dense | (cnt == 8u ? 0x100u : 0u);
  }
  __syncthreads();
#define GSYNC() { bar_target += 1u; grp_barrier(P.bar, bar_target, xst); }
#define RUNP(k) { run_phase<k>(P, l, smem, nb, bid, xst); GSYNC(); if (DUP_MASK & (1 << k)) { run_phase<k>(P, l, smem, nb, bid, xst); GSYNC(); } }
  for (int l = 0; l < NL; ++l) {
    RUNP(1) RUNP(2) RUNP(3) RUNP(4) RUNP(5) RUNP(6) RUNP(7) RUNP(8) RUNP(9) RUNP(10)
  }
  run_phase<11>(P, 0, smem, nb, bid, xst);
}
#else
template <int PH> __global__ void __launch_bounds__(NTHR, 2) phase_kernel(Params P, int l) {
  __shared__ __attribute__((aligned(16))) char smem_raw[SMEM_BYTES];
  run_phase<PH>(P, l, (lptr)smem_raw, gridDim.x, blockIdx.x, nullptr);
}
#endif

extern "C" void kernel_launch(void* const* d_in, const int* in_sizes, int n_in, void* d_out, int out_size, void* d_ws, size_t ws_size,
                              hipStream_t stream) {
  Params P{};
  P.x = (const float*)d_in[0]; P.pos = (const int*)d_in[1];
  const float** fp = &P.mix_norm;
  for (int i = 0; i < 28; ++i) fp[i] = (const float*)d_in[2 + i];
  P.out = (float*)d_out;
  char* ws = (char*)d_ws; size_t off = 0;
  auto take = [&](size_t bytes) { char* p = ws + off; off += (bytes + 255) & ~(size_t)255; return p; };
  P.xres = (float*)take((size_t)T * D * 4);
  P.hb = (bf16_t*)take((size_t)T * D * 2);
  P.mixed = (bf16_t*)take((size_t)T * D * 2);
  P.proj = (bf16_t*)take((size_t)T * PW * 2);
  P.preA = (bf16_t*)take((size_t)T * 256 * 2);
  P.preB = (bf16_t*)take((size_t)T * 256 * 2);
  P.preC = (bf16_t*)take((size_t)T * 256 * 2);
  P.hidden = P.proj;
  P.Xc = (bf16_t*)take((size_t)T * 512 * 2);
  P.fft1 = (bf16_t*)take((size_t)2 * 128 * 128 * 256 * 2);
  P.wb = (bf16_t*)take((size_t)WB_ELEMS * 2);
  P.Qb = (bf16_t*)take((size_t)T * 4 * 96 * 2);
  P.Kb = (bf16_t*)take((size_t)T * 4 * 96 * 2);
  P.Vt = (bf16_t*)take((size_t)T * 256 * 2);
  P.LW = (bf16_t*)take((size_t)2 * T * 256 * 2);
  P.AA = (bf16_t*)take((size_t)2 * T * 256 * 2);
  P.Gg = (bf16_t*)take((size_t)T * 256 * 2);
  P.YS = (float*)take((size_t)2 * T * 256 * 4);
  P.Wf = (bf16_t*)take((size_t)NL * 512 * 1024 * 2);
  P.ropeC = (float*)take((size_t)T * 16 * 4);
  P.ropeS = (float*)take((size_t)T * 16 * 4);
  P.tabC = (bf16_t*)take(128 * 128 * 2);
  P.tabMS = (bf16_t*)take(128 * 128 * 2);
  P.tabT2 = (bf16_t*)take(128 * 128 * 2);
  P.bar = (unsigned*)take(64 * (5 * NG + 3) * 4);
  for (int i = 0; i < 16; ++i) P.invf[i] = pow(10000.0, -(double)i / 16.0);
  if (off > ws_size) { fprintf(stderr, "workspace too small: need %zu have %zu\n", off, ws_size); return; }
#if !MULTI_LAUNCH
  static int grid_blocks = 0;
  if (!grid_blocks) {
    int dev = 0, cus = 0, per_cu = 0;
    hipGetDevice(&dev);
    hipDeviceGetAttribute(&cus, hipDeviceAttributeMultiprocessorCount, dev);
    hipOccupancyMaxActiveBlocksPerMultiprocessor(&per_cu, mega_kernel, NTHR, 0);
    if (per_cu > 2) per_cu = 2;
    grid_blocks = cus * per_cu;
  }
  (void)hipMemsetAsync(P.bar, 0, 64 * (5 * NG + 3) * 4, stream);
  void* args[] = {&P};
  hipError_t e = hipLaunchCooperativeKernel((void*)mega_kernel, dim3(grid_blocks), dim3(NTHR), args, 0, stream);
  if (e != hipSuccess) fprintf(stderr, "cooperative launch failed: %s (grid %d)\n", hipGetErrorString(e), grid_blocks);
#else
  const int G = 512;
  phase_kernel<0><<<G, NTHR, 0, stream>>>(P, 0);
  for (int l = 0; l < NL; ++l) {
    phase_kernel<1><<<G, NTHR, 0, stream>>>(P, l);
    phase_kernel<2><<<G, NTHR, 0, stream>>>(P, l);
    phase_kernel<3><<<G, NTHR, 0, stream>>>(P, l);
    phase_kernel<4><<<G, NTHR, 0, stream>>>(P, l);
    phase_kernel<5><<<G, NTHR, 0, stream>>>(P, l);
    phase_kernel<6><<<G, NTHR, 0, stream>>>(P, l);
    phase_kernel<7><<<G, NTHR, 0, stream>>>(P, l);
    phase_kernel<8><<<G, NTHR, 0, stream>>>(P, l);
    phase_kernel<9><<<G, NTHR, 0, stream>>>(P, l);
    phase_kernel<10><<<G, NTHR, 0, stream>>>(P, l);
  }
  phase_kernel<11><<<G, NTHR, 0, stream>>>(P, 0);
#endif
}
```

```cpp
#include <hip/hip_runtime.h>
#include <hip/hip_cooperative_groups.h>
#include <cstdio>
#include <cmath>
namespace cg = cooperative_groups;

#define DI __device__ __forceinline__
#ifndef USE_TR
#define USE_TR 1
#endif
#ifndef DUP_MASK
#define DUP_MASK 0
#endif
#ifndef MULTI_LAUNCH
#define MULTI_LAUNCH 0
#endif

typedef __attribute__((address_space(3))) char* lptr;
#define LAS __attribute__((address_space(3)))
typedef short bf16x8 __attribute__((ext_vector_type(8)));
typedef short s16x4 __attribute__((ext_vector_type(4)));
typedef short v4i16_t __attribute__((vector_size(8)));
typedef float f32x16 __attribute__((ext_vector_type(16)));
typedef float f32x4 __attribute__((ext_vector_type(4)));
typedef float f32x2 __attribute__((ext_vector_type(2)));
typedef __bf16 bf16x2_t __attribute__((ext_vector_type(2)));
typedef unsigned u32x4 __attribute__((ext_vector_type(4)));
typedef unsigned u32x2 __attribute__((ext_vector_type(2)));
typedef unsigned short bf16_t;

constexpr int T = 16384, S = 8192, D = 1024, NL = 4, INW = 6688, PW = 2592, DFF = 2816;
constexpr int C_CX = 0, C_CB = 256, C_CC = 512, C_R = 768, C_K = 1024, C_V = 1280, C_WLO = 1536, C_ALO = 1664, C_GLO = 1792,
              C_QLO = 1920, C_KVLO = 2176, C_FIN = 2336, C_GATE = 2592;
constexpr int NTHR = 256;
constexpr int O_WIN = 0, O_CONV = O_WIN + D * INW, O_RWKV = O_CONV + 256 * D, O_MLA = O_RWKV + 256 * D, O_WO = O_MLA + 256 * D,
              O_GU = O_WO + D * D, O_DOWN = O_GU + D * 2 * DFF, O_UQ = O_DOWN + DFF * D, O_UKV = O_UQ + 256 * 384, O_WUP = O_UKV + 128 * 512,
              O_AUP = O_WUP + 2 * 64 * 256, O_GUP = O_AUP + 2 * 64 * 256, WB_ELEMS = O_GUP + 128 * 256;
constexpr int SMEM_BYTES = 57344;

DI unsigned pk2(float a, float b) { f32x2 v = {a, b}; bf16x2_t r = __builtin_convertvector(v, bf16x2_t); return __builtin_bit_cast(unsigned, r); }
DI bf16_t f2bf(float x) { return (bf16_t)(pk2(x, 0.f) & 0xffffu); }
DI float bf2f(bf16_t v) { return __uint_as_float(((unsigned)v) << 16); }
DI float bflo(unsigned u) { return __uint_as_float(u << 16); }
DI float bfhi(unsigned u) { return __uint_as_float(u & 0xffff0000u); }
DI float wave_sum(float x) {
#pragma unroll
  for (int o = 32; o >= 1; o >>= 1) x += __shfl_xor(x, o);
  return x;
}
DI float sigmoidf_(float x) { return __builtin_amdgcn_rcpf(1.f + __expf(-x)); }
DI float tanhf_(float x) { float e = __expf(-2.f * fabsf(x)); float t = (1.f - e) * __builtin_amdgcn_rcpf(1.f + e); return x < 0.f ? -t : t; }
DI s16x4 trr(lptr p) { return __builtin_bit_cast(s16x4, __builtin_amdgcn_ds_read_tr16_b64_v4i16((LAS v4i16_t*)p)); }
DI int otid() { int t = threadIdx.x; asm volatile("" : "+v"(t)); return t; }
DI int crow(int i, int h) { return (i & 3) + 8 * (i >> 2) + 4 * h; }

struct Params {
  const float* x; const int* pos;
  const float *mix_norm, *w_in, *gate_bias, *conv_w, *conv_out, *rwkv_mu, *rwkv_w0, *rwkv_w_up, *rwkv_a0, *rwkv_a_up, *rwkv_g_up,
      *rwkv_k_k, *rwkv_k_a, *rwkv_r_k, *rwkv_ln_g, *rwkv_ln_b, *rwkv_out, *mla_q_norm, *mla_w_uq, *mla_kv_norm, *mla_w_ukv, *mla_out,
      *fnet_out, *w_o, *ffn_norm, *ffn_w_gu, *ffn_w_down, *final_norm;
  float* out;
  float* xres; bf16_t *hb, *mixed, *proj, *preA, *preB, *preC, *Xc, *hidden; bf16_t* fft1; bf16_t* wb;
  bf16_t *Qb, *Kb, *Vt, *LW, *AA, *Gg; float* YS; bf16_t* Wf; float *ropeC, *ropeS; bf16_t *tabC, *tabMS, *tabT2;
  unsigned* bar;
  double invf[16];
};

constexpr int SA_STRIDE = 144;
constexpr int SA_BYTES = 128 * SA_STRIDE;
constexpr int GEMM_SMEM = SA_BYTES + 64 * 320;

template <int ATR> DI unsigned atr2(unsigned u) {
  if (ATR == 0) return u;
  float a = bflo(u), b = bfhi(u);
  if (ATR == 1) { a = tanhf_(a); b = tanhf_(b); }
  if (ATR == 2) { a = sigmoidf_(a); b = sigmoidf_(b); }
  return pk2(a, b);
}

template <int WN, int ATR, int PD = 2>
DI void gemm_acc(f32x16 (&acc)[2][WN], const bf16_t* __restrict__ A, int lda, const bf16_t* __restrict__ B, int ldb, int K, lptr smem) {
  constexpr int BN = 64 * WN, SBS = BN * 2 + 64, CPR = 8 * WN, NB = 2 * WN, RPP = 256 / CPR;
  int tid_ = threadIdx.x; asm volatile("" : "+v"(tid_));
  const int tid = tid_, lane = tid & 63, w = tid >> 6, wm = w >> 1, wn = w & 1;
  const int r = lane & 31, h = lane >> 5;
  const int q = (lane & 15) >> 2, p = lane & 3, blk = (lane >> 4) & 1;
  lptr sA = smem, sB = smem + SA_BYTES;
  u32x4 ra0[4], ra1[4], ra2[4], rb0[NB], rb1[NB], rb2[NB];
  const int nk = K >> 6;
  const unsigned aoff = (unsigned)(((tid >> 3) * lda + (tid & 7) * 8) * 2), astep = (unsigned)(32 * lda * 2);
  const unsigned boff = (unsigned)(((tid / CPR) * ldb + (tid % CPR) * 8) * 2), bstep = (unsigned)(RPP * ldb * 2);
  const unsigned sao = (unsigned)((tid >> 3) * SA_STRIDE + (tid & 7) * 16), sbo = (unsigned)((tid / CPR) * SBS + (tid % CPR) * 16);
  const char* Ac = (const char*)A; const char* Bc = (const char*)B;
  const long bkstep = (long)ldb * 128;
  auto loadt = [&](u32x4 (&ra)[4], u32x4 (&rb)[NB], int kt) {
    const char* a = Ac + kt * 128; const char* b = Bc + kt * bkstep;
#pragma unroll
    for (int i = 0; i < 4; ++i) ra[i] = *(const u32x4*)(a + (aoff + i * astep));
#pragma unroll
    for (int i = 0; i < NB; ++i) rb[i] = *(const u32x4*)(b + (boff + i * bstep));
  };
  auto step = [&](u32x4 (&ra)[4], u32x4 (&rb)[NB], int kt) {
    __syncthreads();
#pragma unroll
    for (int i = 0; i < 4; ++i) {
      u32x4 v = ra[i];
      if (ATR != 0) { v.x = atr2<ATR>(v.x); v.y = atr2<ATR>(v.y); v.z = atr2<ATR>(v.z); v.w = atr2<ATR>(v.w); }
      *(LAS u32x4*)(sA + sao + i * 32 * SA_STRIDE) = v;
    }
#pragma unroll
    for (int i = 0; i < NB; ++i) *(LAS u32x4*)(sB + sbo + i * RPP * SBS) = rb[i];
    __syncthreads();
    loadt(ra, rb, kt + PD < nk ? kt + PD : nk - 1);
    lptr pa = sA + (wm * 64 + r) * SA_STRIDE + 16 * h;
    lptr pb = sB + (8 * h + q) * SBS + (wn * 32 * WN + 16 * blk + 4 * p) * 2;
#pragma unroll
    for (int s = 0; s < 4; ++s) {
      bf16x8 af[2];
#pragma unroll
      for (int mi = 0; mi < 2; ++mi) af[mi] = *(LAS bf16x8*)(pa + mi * 32 * SA_STRIDE + 32 * s);
#pragma unroll
      for (int nj = 0; nj < WN; ++nj) {
        s16x4 lo = trr(pb + 16 * s * SBS + nj * 64), hi = trr(pb + (16 * s + 4) * SBS + nj * 64);
        const bf16x8 bfr = __builtin_shufflevector(lo, hi, 0, 1, 2, 3, 4, 5, 6, 7);
#pragma unroll
        for (int mi = 0; mi < 2; ++mi) acc[mi][nj] = __builtin_amdgcn_mfma_f32_32x32x16_bf16(af[mi], bfr, acc[mi][nj], 0, 0, 0);
      }
    }
  };
  loadt(ra0, rb0, 0);
  __builtin_amdgcn_sched_barrier(0);
  loadt(ra1, rb1, nk > 1 ? 1 : 0);
  __builtin_amdgcn_sched_barrier(0);
  if (PD == 3) { loadt(ra2, rb2, nk > 2 ? 2 : nk - 1); __builtin_amdgcn_sched_barrier(0); }
  if (PD == 3) {
    int kt = 0;
#pragma unroll 1
    for (; kt + 2 < nk; kt += 3) { step(ra0, rb0, kt); step(ra1, rb1, kt + 1); step(ra2, rb2, kt + 2); }
    if (kt < nk) step(ra0, rb0, kt);
    if (kt + 1 < nk) step(ra1, rb1, kt + 1);
  } else {
#pragma unroll 1
    for (int kt = 0; kt < nk; kt += 2) {
      step(ra0, rb0, kt);
      if (kt + 1 < nk) step(ra1, rb1, kt + 1);
    }
  }
}

template <int WN> DI void acc_zero(f32x16 (&acc)[2][WN]) {
#pragma unroll
  for (int mi = 0; mi < 2; ++mi)
#pragma unroll
    for (int nj = 0; nj < WN; ++nj)
#pragma unroll
      for (int i = 0; i < 16; ++i) acc[mi][nj][i] = 0.f;
}
template <int WN, class F> DI void epi_each(F f) {
  int tid_ = threadIdx.x; asm volatile("" : "+v"(tid_));
  const int lane = tid_ & 63, w = tid_ >> 6, wm = w >> 1, wn = w & 1, r = lane & 31, h = lane >> 5;
#pragma unroll
  for (int mi = 0; mi < 2; ++mi)
#pragma unroll
    for (int nj = 0; nj < WN; ++nj)
#pragma unroll
      for (int i = 0; i < 16; ++i) f(mi, nj, i, wm * 64 + mi * 32 + crow(i, h), wn * 32 * WN + nj * 32 + r);
}

constexpr int NG = 16;
DI unsigned bar_ld(unsigned* p) { return __hip_atomic_load(p, __ATOMIC_RELAXED, __HIP_MEMORY_SCOPE_AGENT); }
DI unsigned bar_add(unsigned* p) { return __hip_atomic_fetch_add(p, 1u, __ATOMIC_RELAXED, __HIP_MEMORY_SCOPE_AGENT); }
DI unsigned xcc_id() { return (unsigned)__builtin_amdgcn_s_getreg((3 << 11) | 20) & 0xFu; }
DI void grp_barrier(unsigned* bar, unsigned k, volatile LAS unsigned* st) {
  asm volatile("s_waitcnt vmcnt(0) lgkmcnt(0)" ::: "memory");
  __syncthreads();
  if (threadIdx.x == 0) {
    const unsigned g = xcc_id(), gsize = st[0], ng = st[1];
    const unsigned old = bar_add(bar + 64 * g);
    if (old + 1u == k * gsize) {
      __builtin_amdgcn_fence(__ATOMIC_RELEASE, "agent");
      asm volatile("s_waitcnt vmcnt(0)" ::: "memory");
      (void)bar_add(bar + 64 * (2 * NG));
      while (bar_ld(bar + 64 * (2 * NG)) < k * ng) { }
      __builtin_amdgcn_fence(__ATOMIC_ACQUIRE, "agent");
      (void)bar_add(bar + 64 * (NG + g));
      asm volatile("s_waitcnt vmcnt(0)" ::: "memory");
    } else {
      while (bar_ld(bar + 64 * (NG + g)) < k) { }
      __builtin_amdgcn_fence(__ATOMIC_ACQUIRE, "agent");
      asm volatile("s_waitcnt vmcnt(0)" ::: "memory");
    }
  }
  __syncthreads();
}

DI void sub_barrier(unsigned* bar, unsigned k, unsigned r, unsigned n) {
  asm volatile("s_waitcnt vmcnt(0) lgkmcnt(0)" ::: "memory");
  __syncthreads();
  if (threadIdx.x == 0) {
    const unsigned g = r % NG, gsize = (n - g + NG - 1) / NG, ng = n < (unsigned)NG ? n : (unsigned)NG;
    __builtin_amdgcn_fence(__ATOMIC_RELEASE, "agent");
    asm volatile("s_waitcnt vmcnt(0)" ::: "memory");
    const unsigned old = bar_add(bar + 64 * g);
    if (old + 1u == k * gsize) {
      (void)bar_add(bar + 64 * (2 * NG));
      while (bar_ld(bar + 64 * (2 * NG)) < k * ng) { }
      (void)bar_add(bar + 64 * (NG + g));
    } else {
      while (bar_ld(bar + 64 * (NG + g)) < k) { }
    }
    __builtin_amdgcn_fence(__ATOMIC_ACQUIRE, "agent");
    asm volatile("s_waitcnt vmcnt(0)" ::: "memory");
  }
  __syncthreads();
}

struct TileIt { int j, stride, count, base, xmode; };
DI TileIt tile_it(volatile LAS unsigned* xs, int NT, int nb, int bid) {
  TileIt t; const unsigned info = xs ? xs[3] : 0u;
  if (info & 0x100u) { t.xmode = 1; t.j = (int)xs[2]; t.stride = (int)xs[0]; t.count = 16 * NT; t.base = (int)(info & 0xffu) * 16; }
  else { t.xmode = 0; t.j = bid; t.stride = nb; t.count = 128 * NT; t.base = 0; }
  return t;
}
DI void tile_get(const TileIt& t, int NT, int& mt, int& nt) { if (t.xmode) { mt = t.base + (t.j & 15); nt = t.j >> 4; } else { mt = t.j / NT; nt = t.j % NT; } }

template <bool OUTF32>
DI void phase_norm(const float* __restrict__ src, const float* __restrict__ gain, bf16_t* __restrict__ dstb, float* __restrict__ dstf, int nb, int bid) {
  const int tid0 = otid(); const int lane = tid0 & 63, w = tid0 >> 6;
  for (int row = bid * 4 + w; row < T; row += nb * 4) {
    const float* xr = src + (long)row * D;
    f32x4 v[4]; float ss = 0.f;
#pragma unroll
    for (int i = 0; i < 4; ++i) { v[i] = *(const f32x4*)(xr + i * 256 + lane * 4); ss += v[i].x * v[i].x + v[i].y * v[i].y + v[i].z * v[i].z + v[i].w * v[i].w; }
    ss = wave_sum(ss);
    const float rinv = rsqrtf(ss * (1.f / D) + 1e-6f);
#pragma unroll
    for (int i = 0; i < 4; ++i) {
      const f32x4 g = *(const f32x4*)(gain + i * 256 + lane * 4);
      const float a = v[i].x * rinv * g.x, b = v[i].y * rinv * g.y, c = v[i].z * rinv * g.z, d = v[i].w * rinv * g.w;
      if (OUTF32) { f32x4 o = {a, b, c, d}; *(f32x4*)(dstf + (long)row * D + i * 256 + lane * 4) = o; }
      else { u32x2 o; o.x = pk2(a, b); o.y = pk2(c, d); *(u32x2*)(dstb + (long)row * D + i * 256 + lane * 4) = o; }
    }
  }
}

DI void cvt_seg(bf16_t* __restrict__ dst, const float* __restrict__ src, int n, int rowlen, const float* __restrict__ rscale, long gtid, long gn) {
  for (long e = gtid; e < (n >> 2); e += gn) {
    f32x4 v = *(const f32x4*)(src + e * 4);
    if (rscale) { const float sc = rscale[(int)((e * 4) / rowlen)]; v.x *= sc; v.y *= sc; v.z *= sc; v.w *= sc; }
    u32x2 o; o.x = pk2(v.x, v.y); o.y = pk2(v.z, v.w);
    *(u32x2*)(dst + e * 4) = o;
  }
}
DI void phase_cvt_weights(const Params& P, int l, int nb, int bid) {
  const long gtid = (long)bid * NTHR + otid(), gn = (long)nb * NTHR;
  cvt_seg(P.wb + O_WIN, P.w_in + (long)l * D * INW, D * INW, 1, nullptr, gtid, gn);
  cvt_seg(P.wb + O_CONV, P.conv_out + (long)l * 256 * D, 256 * D, 1, nullptr, gtid, gn);
  cvt_seg(P.wb + O_RWKV, P.rwkv_out + (long)l * 256 * D, 256 * D, 1, nullptr, gtid, gn);
  cvt_seg(P.wb + O_MLA, P.mla_out + (long)l * 256 * D, 256 * D, 1, nullptr, gtid, gn);
  cvt_seg(P.wb + O_WO, P.w_o + (long)l * D * D, D * D, 1, nullptr, gtid, gn);
  cvt_seg(P.wb + O_GU, P.ffn_w_gu + (long)l * D * 2 * DFF, D * 2 * DFF, 1, nullptr, gtid, gn);
  cvt_seg(P.wb + O_DOWN, P.ffn_w_down + (long)l * DFF * D, DFF * D, 1, nullptr, gtid, gn);
  cvt_seg(P.wb + O_UQ, P.mla_w_uq + (long)l * 256 * 384, 256 * 384, 384, P.mla_q_norm + l * 256, gtid, gn);
  cvt_seg(P.wb + O_UKV, P.mla_w_ukv + (long)l * 128 * 512, 128 * 512, 512, P.mla_kv_norm + l * 128, gtid, gn);
  cvt_seg(P.wb + O_WUP, P.rwkv_w_up + (long)l * 2 * 64 * 256, 2 * 64 * 256, 1, nullptr, gtid, gn);
  cvt_seg(P.wb + O_AUP, P.rwkv_a_up + (long)l * 2 * 64 * 256, 2 * 64 * 256, 1, nullptr, gtid, gn);
  cvt_seg(P.wb + O_GUP, P.rwkv_g_up + (long)l * 128 * 256, 128 * 256, 1, nullptr, gtid, gn);
}

DI void phase_prologue(const Params& P, int nb, int bid) {
  const long gtid = (long)bid * NTHR + otid(), gn = (long)nb * NTHR;
  for (long e = gtid; e < (long)T * 16; e += gn) {
    const int t = (int)(e >> 4), i = (int)(e & 15);
    const double rev = (double)P.pos[t] * P.invf[i] * 0.15915494309189535;
    const float fr = (float)(rev - floor(rev));
    P.ropeC[e] = __builtin_amdgcn_cosf(fr); P.ropeS[e] = __builtin_amdgcn_sinf(fr);
  }
  for (long e = gtid; e < 128 * 128; e += gn) {
    const int k1 = (int)(e >> 7), n1 = (int)(e & 127);
    const float fr = (float)((k1 * n1) & 127) * (1.f / 128.f);
    P.tabC[e] = f2bf(__builtin_amdgcn_cosf(fr)); P.tabMS[e] = f2bf(-__builtin_amdgcn_sinf(fr));
    const int part = k1 >> 6, k2 = k1 & 63, cpart = n1 >> 6, n2 = n1 & 63;
    const float f2 = (float)((k2 * n2) & 63) * (1.f / 64.f);
    const float c = __builtin_amdgcn_cosf(f2), s = __builtin_amdgcn_sinf(f2);
    float v = (part == 0) ? (cpart == 0 ? c : s) : (cpart == 0 ? -s : c);
    P.tabT2[e] = f2bf(v);
  }
  const float scl = 1.f / sqrtf((float)S * 64.f);
  for (long e = gtid; e < (long)NL * 512 * 1024; e += gn) {
    const int n = (int)(e & 1023), row = (int)((e >> 10) & 511), l = (int)(e >> 19);
    const int part = row >> 8, g = (row >> 6) & 3, c = row & 63;
    const float* wo = P.fnet_out + ((long)l * 256 + g * 64) * 1024 + n;
    float acc = 0.f;
    for (int c2 = 0; c2 < 64; ++c2) {
      const float fr = (float)((c * c2) & 63) * (1.f / 64.f);
      const float tv = part == 0 ? __builtin_amdgcn_cosf(fr) : __builtin_amdgcn_sinf(fr);
      acc += tv * wo[(long)c2 * 1024];
    }
    P.Wf[e] = f2bf(acc * scl);
  }
}

DI void phase_inproj(const Params& P, int l, lptr smem, int nb, int bid, volatile LAS unsigned* xs) {
  for (TileIt it = tile_it(xs, 21, nb, bid); it.j < it.count; it.j += it.stride) {
    int mt, nt; tile_get(it, 21, mt, nt);
    f32x16 acc[2][2]; acc_zero<2>(acc);
    gemm_acc<2, 0, 3>(acc, P.hb + (long)mt * 128 * D, D, P.wb + O_WIN + nt * 128, INW, D, smem);
    epi_each<2>([&](int mi, int nj, int i, int rl, int cl) {
      const int row = mt * 128 + rl, col = nt * 128 + cl; const float v = acc[mi][nj][i];
      if (col < PW) P.proj[(long)row * PW + col] = f2bf(v);
    });
  }
}

DI void job_conv(const Params& P, int l, int mt) {
  const float* cw = P.conv_w + (long)l * 3 * 256;
  for (int e = otid(); e < 128 * 256; e += NTHR) {
    const int t = mt * 128 + (e >> 8), c = e & 255, s = t & (S - 1);
    const bf16_t* pr = P.proj + (long)t * PW;
    const float z0 = bf2f(pr[C_CC + c]) * bf2f(pr[C_CX + c]);
    const float zm = s > 0 ? bf2f(pr[C_CC + c - PW]) * bf2f(pr[C_CX + c - PW]) : 0.f;
    const float zp = s < S - 1 ? bf2f(pr[C_CC + c + PW]) * bf2f(pr[C_CX + c + PW]) : 0.f;
    const float y = cw[c] * zm + cw[256 + c] * z0 + cw[512 + c] * zp;
    P.preA[(long)t * 256 + c] = f2bf(bf2f(pr[C_CB + c]) * y);
  }
}

DI void job_mla_prep(const Params& P, int l, int mt, int j, lptr smem) {
  const int tid = otid(), lane = tid & 63, w = tid >> 6;
  LAS float* sR = (LAS float*)(smem + GEMM_SMEM);
  __syncthreads();
  for (int rr = 0; rr < 32; ++rr) {
    const int rl = w * 32 + rr; const bf16_t* pr = P.proj + (long)(mt * 128 + rl) * PW;
    float ss;
    if (j < 3) { const u32x2 u = *(const u32x2*)(pr + C_QLO + lane * 4); const float a = bflo(u.x), b = bfhi(u.x), c = bflo(u.y), d = bfhi(u.y); ss = a * a + b * b + c * c + d * d; }
    else { const unsigned u = *(const unsigned*)(pr + C_KVLO + lane * 2); const float a = bflo(u), b = bfhi(u); ss = a * a + b * b; }
    ss = wave_sum(ss);
    if (lane == 0) sR[rl] = rsqrtf(ss * (j < 3 ? 1.f / 256.f : 1.f / 128.f) + 1e-6f);
  }
  f32x16 acc[2][2]; acc_zero<2>(acc);
  if (j < 3) {
    gemm_acc<2, 0>(acc, P.proj + (long)mt * 128 * PW + C_QLO, PW, P.wb + O_UQ + j * 128, 384, 256, smem);
    const float qs = 0.10206207261596577f * 1.4426950408889634f;
    epi_each<2>([&](int mi, int nj, int i, int rl, int cl) {
      const int t = mt * 128 + rl, col = j * 128 + cl, hh = col / 96, d = col - hh * 96;
      float v = acc[mi][nj][i] * sR[rl] * qs;
      const float pv = __shfl_xor(v, 16);
      if (d >= 64) {
        const float c = P.ropeC[t * 16 + (col & 15)], s = P.ropeS[t * 16 + (col & 15)];
        v = (col & 16) ? (v * c + pv * s) : (v * c - pv * s);
      }
      const int b = t >> 13, sq = t & (S - 1);
      P.Qb[((long)(b * 4 + hh) * S + sq) * 96 + d] = f2bf(v);
    });
  } else {
    const int hh = j - 3;
    gemm_acc<2, 0>(acc, P.proj + (long)mt * 128 * PW + C_KVLO, PW, P.wb + O_UKV + hh * 128, 512, 128, smem);
    const int wn = w & 1, wm = w >> 1, r = lane & 31, h = lane >> 5;
    const int b = (mt * 128) >> 13;
    if (wn == 0) {
      epi_each<2>([&](int mi, int nj, int i, int rl, int cl) {
        const int t = mt * 128 + rl, sq = t & (S - 1);
        P.Kb[((long)(b * 4 + hh) * S + sq) * 96 + cl] = f2bf(acc[mi][nj][i] * sR[rl]);
      });
    } else {
#pragma unroll
      for (int mi = 0; mi < 2; ++mi)
#pragma unroll
        for (int nj = 0; nj < 2; ++nj)
#pragma unroll
          for (int i4 = 0; i4 < 4; ++i4) {
            const int rl = wm * 64 + mi * 32 + 8 * i4 + 4 * h, dv = nj * 32 + r;
            const int sq = (mt * 128 + rl) & (S - 1);
            u32x2 o; o.x = pk2(acc[mi][nj][4 * i4] * sR[rl], acc[mi][nj][4 * i4 + 1] * sR[rl + 1]);
            o.y = pk2(acc[mi][nj][4 * i4 + 2] * sR[rl + 2], acc[mi][nj][4 * i4 + 3] * sR[rl + 3]);
            *(u32x2*)(P.Vt + ((long)(b * 4 + hh) * 64 + dv) * S + sq) = o;
          }
    }
    for (int e = tid; e < 128 * 16; e += NTHR) {
      const int t = mt * 128 + (e >> 4), i = e & 15, sq = t & (S - 1);
      const bf16_t* pr = P.proj + (long)t * PW + C_KVLO + 128;
      const float x1 = bf2f(pr[i]), x2 = bf2f(pr[16 + i]), c = P.ropeC[t * 16 + i], s = P.ropeS[t * 16 + i];
      bf16_t* kd = P.Kb + ((long)(b * 4 + hh) * S + sq) * 96 + 64;
      kd[i] = f2bf(x1 * c - x2 * s); kd[16 + i] = f2bf(x2 * c + x1 * s);
    }
  }
}

DI void job_rwkv_prep(const Params& P, int l, int mt, int which, int nt, lptr smem) {
  f32x16 acc[2][2]; acc_zero<2>(acc);
  const bf16_t* Ab = P.proj + (long)mt * 128 * PW;
  if (which < 2) {
    const int d = which;
    gemm_acc<2, 1>(acc, Ab + C_WLO + d * 64, PW, P.wb + O_WUP + d * 64 * 256 + nt * 128, 256, 64, smem);
    const float* w0 = P.rwkv_w0 + (l * 2 + d) * 256;
    epi_each<2>([&](int mi, int nj, int i, int rl, int cl) {
      const int t = mt * 128 + rl, col = nt * 128 + cl;
      const float z = acc[mi][nj][i] + w0[col];
      const float u = -z; const float sp = fmaxf(u, 0.f) + __logf(1.f + __expf(-fabsf(u)));
      const float wl = -sp - 0.5f;
      P.LW[((long)d * T + t) * 256 + col] = f2bf(-__expf(wl));
    });
  } else if (which < 4) {
    const int d = which - 2;
    gemm_acc<2, 0>(acc, Ab + C_ALO + d * 64, PW, P.wb + O_AUP + d * 64 * 256 + nt * 128, 256, 64, smem);
    const float* a0 = P.rwkv_a0 + (l * 2 + d) * 256;
    epi_each<2>([&](int mi, int nj, int i, int rl, int cl) {
      const int t = mt * 128 + rl, col = nt * 128 + cl;
      P.AA[((long)d * T + t) * 256 + col] = f2bf(sigmoidf_(acc[mi][nj][i] + a0[col]));
    });
  } else {
    gemm_acc<2, 2>(acc, Ab + C_GLO, PW, P.wb + O_GUP + nt * 128, 256, 128, smem);
    epi_each<2>([&](int mi, int nj, int i, int rl, int cl) {
      const int t = mt * 128 + rl, col = nt * 128 + cl;
      P.Gg[(long)t * 256 + col] = f2bf(acc[mi][nj][i]);
    });
  }
}

DI void job_fft1(const Params& P, int b, int n2, int nt, lptr smem) {
  f32x16 are[2][1], aim[2][1]; acc_zero<1>(are); acc_zero<1>(aim);
  const bf16_t* Bp = P.proj + ((long)(b * S + n2)) * PW + C_FIN + nt * 64;
  gemm_acc<1, 0>(are, P.tabC, 128, Bp, 64 * PW, 128, smem);
  gemm_acc<1, 0>(aim, P.tabMS, 128, Bp, 64 * PW, 128, smem);
  epi_each<1>([&](int mi, int nj, int i, int rl, int cl) {
    const int k1 = rl, col = nt * 64 + cl;
    const float fr = (float)((n2 * k1) & 8191) * (1.f / 8192.f);
    const float c = __builtin_amdgcn_cosf(fr), s = __builtin_amdgcn_sinf(fr);
    const float re = are[mi][nj][i], im = aim[mi][nj][i];
    bf16_t* o = P.fft1 + (((long)(b * 128 + k1) * 128) + n2) * 256 + col;
    o[0] = f2bf(re * c + im * s); o[64 * 256] = f2bf(im * c - re * s);
  });
}

DI void phase2(const Params& P, int l, lptr smem, int nb, int bid) {
  for (int job = bid; job < 1280; job += nb) job_rwkv_prep(P, l, job / 10, (job % 10) >> 1, job & 1, smem);
}

#define LDS_SYNC() { asm volatile("s_waitcnt lgkmcnt(0)" ::: "memory"); __syncthreads(); }
DI float dpp_xor1(float x) { return __int_as_float(__builtin_amdgcn_mov_dpp(__float_as_int(x), 0xB1, 0xF, 0xF, true)); }
DI float dpp_xor2(float x) { return __int_as_float(__builtin_amdgcn_mov_dpp(__float_as_int(x), 0x4E, 0xF, 0xF, true)); }

DI float dpp_ror4(float x) { return __int_as_float(__builtin_amdgcn_mov_dpp(__float_as_int(x), 0x124, 0xF, 0xF, true)); }
DI float dpp_ror8(float x) { return __int_as_float(__builtin_amdgcn_mov_dpp(__float_as_int(x), 0x128, 0xF, 0xF, true)); }
DI float row16_sum(float x) { x += dpp_xor1(x); x += dpp_xor2(x); x += dpp_ror4(x); x += dpp_ror8(x); return x; }
DI float rdl(float x, int l) { return __int_as_float(__builtin_amdgcn_readlane(__float_as_int(x), l)); }
DI float wave_sum_fast(float x) { x = row16_sum(x); return (rdl(x, 0) + rdl(x, 16)) + (rdl(x, 32) + rdl(x, 48)); }

struct ScanRaw { bf16_t r[9], k[9], v[9], lw[8], aa[8]; };
constexpr int SCB = 6400;
DI void job_scan(const Params& P, int l, int job, lptr smem) {
  const int chain = job >> 3, v0 = (job & 7) * 8;
  const int d = chain >> 3, b = (chain >> 2) & 1, hh = chain & 3;
  const int tid = otid(), lane = tid & 63, w = tid >> 6;
  LAS float* sbase = (LAS float*)smem;
  if (w >= 2) {
    const int pw = w - 2, ptid = tid - 128;
    const int gc = hh * 64 + lane;
    const float mu_r = P.rwkv_mu[((l * 2 + d) * 3 + 0) * 256 + gc], mu_k = P.rwkv_mu[((l * 2 + d) * 3 + 1) * 256 + gc], mu_v = P.rwkv_mu[((l * 2 + d) * 3 + 2) * 256 + gc];
    const float kkc = P.rwkv_k_k[l * 256 + gc], kac = P.rwkv_k_a[l * 256 + gc];
    ScanRaw raw;
    auto load_raw = [&](int chunk) {
#pragma unroll
      for (int e = 0; e < 9; ++e) {
        const int tau = chunk * 16 + pw * 8 + e - 1;
        const int tc = tau < 0 ? 0 : tau, s = d == 0 ? tc : S - 1 - tc;
        const bf16_t* pr = P.proj + (long)(b * S + s) * PW;
        raw.r[e] = pr[C_R + gc]; raw.k[e] = pr[C_K + gc]; raw.v[e] = pr[C_V + gc];
        if (e > 0) { raw.lw[e - 1] = P.LW[((long)d * T + b * S + s) * 256 + gc]; raw.aa[e - 1] = P.AA[((long)d * T + b * S + s) * 256 + gc]; }
      }
    };
    auto prep = [&](int chunk) {
      LAS float* B = sbase + (chunk & 1) * SCB;
      const bool first = (chunk == 0 && pw == 0);
      float rp = first ? 0.f : bf2f(raw.r[0]), kp = first ? 0.f : bf2f(raw.k[0]), vp = first ? 0.f : bf2f(raw.v[0]);
#pragma unroll
      for (int e = 0; e < 8; ++e) {
        const int i = pw * 8 + e;
        const float r0 = bf2f(raw.r[e + 1]), k0 = bf2f(raw.k[e + 1]), vv0 = bf2f(raw.v[e + 1]);
        const float rd = r0 + mu_r * (rp - r0), kd = k0 + mu_k * (kp - k0), vd = vv0 + mu_v * (vp - vv0);
        rp = r0; kp = k0; vp = vv0;
        const float lw = bf2f(raw.lw[e]), aa = bf2f(raw.aa[e]);
        const float pk_ = kd * kkc, kt = kd * (1.f + (aa - 1.f) * kac);
        const float ss = wave_sum_fast(pk_ * pk_);
        const float inv = __builtin_amdgcn_rsqf(fmaxf(ss, 1e-24f));
        const float kk = pk_ * inv, wd = __expf(lw);
        B[i * 64 + lane] = rd; B[1024 + i * 64 + lane] = wd; B[2048 + i * 64 + lane] = kt;
        B[3072 + i * 64 + lane] = kk; B[4096 + i * 64 + lane] = kk * aa; B[5120 + i * 64 + lane] = vd;
      }
    };
    load_raw(0);
    prep(0);
    load_raw(1);
    for (int c = 0; c <= 512; ++c) {
      LDS_SYNC();
      if (c > 0) {
        const int i = ptid >> 3, cc = ptid & 7;
        const int tau = (c - 1) * 16 + i, s = d == 0 ? tau : S - 1 - tau;
        P.YS[((long)d * T + b * S + s) * 256 + hh * 64 + v0 + cc] = sbase[((c - 1) & 1) * SCB + 6176 + i * 8 + cc];
      }
      if (c < 511) { prep(c + 1); load_raw(c + 2 < 512 ? c + 2 : 511); }
    }
  } else {
    const int vr = w * 4 + (lane >> 4), kq = lane & 15;
    f32x4 st = {0.f, 0.f, 0.f, 0.f};
    for (int c = 0; c <= 512; ++c) {
      LDS_SYNC();
      if (c < 512) {
        LAS float* B = sbase + (c & 1) * SCB;
        LAS float* sRD = B; LAS float* sW = B + 1024; LAS float* sKT = B + 2048; LAS float* sKK = B + 3072; LAS float* sBB = B + 4096; LAS float* sV = B + 5120;
        LAS float* sY = B + 6176;
        f32x4 kk4 = *(LAS f32x4*)(sKK + kq * 4), rd4 = *(LAS f32x4*)(sRD + kq * 4), w4 = *(LAS f32x4*)(sW + kq * 4), b4 = *(LAS f32x4*)(sBB + kq * 4), kt4 = *(LAS f32x4*)(sKT + kq * 4);
        float vv = sV[v0 + vr];
        float ykeep = 0.f;
        float ypend = 0.f;
#pragma unroll
        for (int i = 0; i < 16; ++i) {
          const int in = (i + 1) & 15, o = in * 64 + kq * 4;
          const f32x4 nkk4 = *(LAS f32x4*)(sKK + o), nrd4 = *(LAS f32x4*)(sRD + o), nw4 = *(LAS f32x4*)(sW + o), nb4 = *(LAS f32x4*)(sBB + o), nkt4 = *(LAS f32x4*)(sKT + o);
          const float nvv = sV[in * 64 + v0 + vr];
          float sa = (st.x * kk4.x + st.y * kk4.y) + (st.z * kk4.z + st.w * kk4.w);
          float yp = ypend;
          sa += dpp_xor1(sa); yp += dpp_xor1(yp); sa += dpp_xor2(sa); yp += dpp_xor2(yp);
          sa += dpp_ror4(sa); yp += dpp_ror4(yp); sa += dpp_ror8(sa); yp += dpp_ror8(yp);
          if (i > 0) ykeep = kq == i - 1 ? yp : ykeep;
          st.x = st.x * w4.x - sa * b4.x + vv * kt4.x; st.y = st.y * w4.y - sa * b4.y + vv * kt4.y;
          st.z = st.z * w4.z - sa * b4.z + vv * kt4.z; st.w = st.w * w4.w - sa * b4.w + vv * kt4.w;
          ypend = (st.x * rd4.x + st.y * rd4.y) + (st.z * rd4.z + st.w * rd4.w);
          kk4 = nkk4; rd4 = nrd4; w4 = nw4; b4 = nb4; kt4 = nkt4; vv = nvv;
        }
        { const float yp = row16_sum(ypend); ykeep = kq == 15 ? yp : ykeep; }
        sY[kq * 8 + vr] = ykeep;
      }
    }
  }
}

constexpr int SK_STRIDE = 208, SV_STRIDE = 144;
DI void job_attn(const Params& P, int job, lptr smem) {
  const int bh = job >> 6, qb = job & 63, q0 = qb * 128;
  const int tid = otid(), lane = tid & 63, w = tid >> 6, r = lane & 31, h = lane >> 5;
  lptr sK = smem, sV = smem + 64 * SK_STRIDE;
  const bf16_t* Kg = P.Kb + (long)bh * S * 96; const bf16_t* Vg = P.Vt + (long)bh * 64 * S;
  bf16x8 qf[6];
  { const bf16_t* qp = P.Qb + ((long)bh * S + q0 + w * 32 + r) * 96 + 8 * h;
#pragma unroll
    for (int s = 0; s < 6; ++s) qf[s] = *(const bf16x8*)(qp + 16 * s); }
  f32x16 O[2];
#pragma unroll
  for (int i = 0; i < 16; ++i) { O[0][i] = 0.f; O[1][i] = 0.f; }
  float m = -1e30f, lsum = 0.f;
  u32x4 rk[3], rv[2];
#pragma unroll
  for (int i = 0; i < 3; ++i) { const int c = tid + 256 * i; rk[i] = *(const u32x4*)(Kg + (long)(c / 12) * 96 + (c % 12) * 8); }
#pragma unroll
  for (int i = 0; i < 2; ++i) { const int c = tid + 256 * i; rv[i] = *(const u32x4*)(Vg + (long)(c >> 3) * S + (c & 7) * 8); }
  for (int kt = 0; kt < 128; ++kt) {
    __syncthreads();
#pragma unroll
    for (int i = 0; i < 3; ++i) { const int c = tid + 256 * i; *(LAS u32x4*)(sK + (c / 12) * SK_STRIDE + (c % 12) * 16) = rk[i]; }
#pragma unroll
    for (int i = 0; i < 2; ++i) { const int c = tid + 256 * i; *(LAS u32x4*)(sV + (c >> 3) * SV_STRIDE + (c & 7) * 16) = rv[i]; }
    __syncthreads();
    if (kt + 1 < 128) {
      const int k0 = (kt + 1) * 64;
#pragma unroll
      for (int i = 0; i < 3; ++i) { const int c = tid + 256 * i; rk[i] = *(const u32x4*)(Kg + (long)(k0 + c / 12) * 96 + (c % 12) * 8); }
#pragma unroll
      for (int i = 0; i < 2; ++i) { const int c = tid + 256 * i; rv[i] = *(const u32x4*)(Vg + (long)(c >> 3) * S + k0 + (c & 7) * 8); }
    }
    f32x16 sc[2];
#pragma unroll
    for (int ks = 0; ks < 2; ++ks) {
#pragma unroll
      for (int i = 0; i < 16; ++i) sc[ks][i] = 0.f;
#pragma unroll
      for (int s = 0; s < 6; ++s) {
        const bf16x8 kf = *(LAS bf16x8*)(sK + (ks * 32 + r) * SK_STRIDE + (16 * s + 8 * h) * 2);
        sc[ks] = __builtin_amdgcn_mfma_f32_32x32x16_bf16(kf, qf[s], sc[ks], 0, 0, 0);
      }
    }
    float mx = sc[0][0];
#pragma unroll
    for (int i = 0; i < 16; ++i) { mx = fmaxf(mx, sc[0][i]); mx = fmaxf(mx, sc[1][i]); }
    mx = fmaxf(mx, __shfl_xor(mx, 32));
    const float mn = fmaxf(m, mx), alpha = __builtin_amdgcn_exp2f(m - mn);
    m = mn;
    float rs = 0.f;
#pragma unroll
    for (int ks = 0; ks < 2; ++ks)
#pragma unroll
      for (int i = 0; i < 16; ++i) { const float pe = __builtin_amdgcn_exp2f(sc[ks][i] - mn); sc[ks][i] = pe; rs += pe; }
    lsum = lsum * alpha + rs;
#pragma unroll
    for (int i = 0; i < 16; ++i) { O[0][i] *= alpha; O[1][i] *= alpha; }
#pragma unroll
    for (int ks = 0; ks < 2; ++ks)
#pragma unroll
      for (int s2 = 0; s2 < 2; ++s2) {
        u32x4 pw; pw.x = pk2(sc[ks][8 * s2], sc[ks][8 * s2 + 1]); pw.y = pk2(sc[ks][8 * s2 + 2], sc[ks][8 * s2 + 3]);
        pw.z = pk2(sc[ks][8 * s2 + 4], sc[ks][8 * s2 + 5]); pw.w = pk2(sc[ks][8 * s2 + 6], sc[ks][8 * s2 + 7]);
        const bf16x8 pf = __builtin_bit_cast(bf16x8, pw);
        const int kb = ks * 32 + 16 * s2;
#pragma unroll
        for (int dvt = 0; dvt < 2; ++dvt) {
          lptr vp = sV + (dvt * 32 + r) * SV_STRIDE + (kb + 4 * h) * 2;
          const s16x4 lo = *(LAS s16x4*)vp, hi = *(LAS s16x4*)(vp + 16);
          const bf16x8 vf = __builtin_shufflevector(lo, hi, 0, 1, 2, 3, 4, 5, 6, 7);
          O[dvt] = __builtin_amdgcn_mfma_f32_32x32x16_bf16(vf, pf, O[dvt], 0, 0, 0);
        }
      }
  }
  lsum += __shfl_xor(lsum, 32);
  const float inv = 1.f / lsum;
  const int b = bh >> 2, hh = bh & 3;
  bf16_t* op = P.preC + ((long)(b * S + q0 + w * 32 + r)) * 256 + hh * 64;
#pragma unroll
  for (int dvt = 0; dvt < 2; ++dvt)
#pragma unroll
    for (int i4 = 0; i4 < 4; ++i4) {
      u32x2 o; o.x = pk2(O[dvt][4 * i4] * inv, O[dvt][4 * i4 + 1] * inv); o.y = pk2(O[dvt][4 * i4 + 2] * inv, O[dvt][4 * i4 + 3] * inv);
      *(u32x2*)(op + dvt * 32 + 8 * i4 + 4 * h) = o;
    }
}

DI void job_fft2(const Params& P, int b, int k1, int nt, lptr smem) {
  f32x16 acc[2][2]; acc_zero<2>(acc);
  gemm_acc<2, 0>(acc, P.tabT2, 128, P.fft1 + ((long)(b * 128 + k1) * 128) * 256 + nt * 128, 256, 128, smem);
  epi_each<2>([&](int mi, int nj, int i, int rl, int cl) {
    const int part = rl >> 6, k2 = rl & 63, s = k1 + 128 * k2;
    P.Xc[((long)(b * S + s)) * 512 + part * 256 + nt * 128 + cl] = f2bf(acc[mi][nj][i]);
  });
}

template <int MASK> DI void phase5(const Params& P, int l, lptr smem, int nb, int bid, volatile LAS unsigned* xs, unsigned* dynctr);
DI void phase3(const Params& P, int l, lptr smem, int nb, int bid) {
  if (bid < 128) { __builtin_amdgcn_s_setprio(3); job_scan(P, l, bid, smem); __builtin_amdgcn_s_setprio(0); return; }
  const int r = bid - 128, n = nb - 128;
  for (int job = r; job < 128 + 896 + 512; job += n) {
    if (job < 128) job_conv(P, l, job);
    else if (job < 1024) { const int e = job - 128; job_mla_prep(P, l, e / 7, e % 7, smem); }
    else { const int e = job - 1024; job_fft1(P, e >> 8, (e >> 2) & 63, e & 3, smem); }
  }
  sub_barrier(P.bar + 64 * (3 * NG + 1), (unsigned)(2 * l + 1), (unsigned)r, (unsigned)n);
  for (int job = r; job < 512 + 512; job += n) {
    if (job < 512) job_attn(P, job, smem);
    else { const int e = job - 512; job_fft2(P, e >> 8, (e >> 1) & 127, e & 1, smem); }
  }
  phase5<1>(P, l, smem, n, r, nullptr, P.bar + 64 * (5 * NG + 2) + l);
  sub_barrier(P.bar + 64 * (3 * NG + 1), (unsigned)(2 * l + 2), (unsigned)r, (unsigned)n);
  phase5<4 | 8>(P, l, smem, n, r, nullptr, nullptr);
}

DI void phase4(const Params& P, int l, int nb, int bid) {
  const int tid0 = otid(); const int lane = tid0 & 63, hh = tid0 >> 6, gc = hh * 64 + lane;
  const float lng = P.rwkv_ln_g[l * 256 + gc], lnb = P.rwkv_ln_b[l * 256 + gc], rk = P.rwkv_r_k[l * 256 + gc], kac = P.rwkv_k_a[l * 256 + gc];
  float mu[2][3];
#pragma unroll
  for (int d = 0; d < 2; ++d)
#pragma unroll
    for (int i = 0; i < 3; ++i) mu[d][i] = P.rwkv_mu[((l * 2 + d) * 3 + i) * 256 + gc];
  for (int t = bid; t < T; t += nb) {
    const int s = t & (S - 1);
    const float y = P.YS[(long)t * 256 + gc] + P.YS[((long)T + t) * 256 + gc];
    const float mean = wave_sum_fast(y) * (1.f / 64.f); const float dy = y - mean;
    const float var = wave_sum_fast(dy * dy) * (1.f / 64.f);
    const float yn = dy * rsqrtf(var + 64e-5f) * lng + lnb;
    const bf16_t* pr = P.proj + (long)t * PW;
    const float r0 = bf2f(pr[C_R + gc]), k0 = bf2f(pr[C_K + gc]), v0 = bf2f(pr[C_V + gc]);
    float bonus = 0.f;
#pragma unroll
    for (int d = 0; d < 2; ++d) {
      const bool valid = d == 0 ? (s > 0) : (s < S - 1);
      const bf16_t* pn = d == 0 ? pr - PW : pr + PW;
      const float rn = valid ? bf2f(pn[C_R + gc]) : 0.f, kn = valid ? bf2f(pn[C_K + gc]) : 0.f, vn = valid ? bf2f(pn[C_V + gc]) : 0.f;
      const float rd = r0 + mu[d][0] * (rn - r0), kd = k0 + mu[d][1] * (kn - k0), vd = v0 + mu[d][2] * (vn - v0);
      const float aa = bf2f(P.AA[((long)d * T + t) * 256 + gc]);
      const float kt = kd * (1.f + (aa - 1.f) * kac);
      bonus += wave_sum_fast(rd * kt * rk) * vd;
    }
    P.preB[(long)t * 256 + gc] = f2bf((yn + bonus) * bf2f(P.Gg[(long)t * 256 + gc]));
  }
}

template <int MASK>
DI void phase5(const Params& P, int l, lptr smem, int nb, int bid, volatile LAS unsigned* xs, unsigned* dynctr) {
  LAS int* sj = (LAS int*)(smem + 40960);
  TileIt it = tile_it(xs, 8, nb, bid);
  for (;;) {
    int mt, nt;
    if (dynctr) {
      __syncthreads();
      if (threadIdx.x == 0) *sj = (int)__hip_atomic_fetch_add(dynctr, 1u, __ATOMIC_RELAXED, __HIP_MEMORY_SCOPE_AGENT);
      __syncthreads();
      const int tile = *sj; if (tile >= 1024) break;
      mt = tile >> 3; nt = tile & 7;
    } else {
      if (it.j >= it.count) break;
      tile_get(it, 8, mt, nt); it.j += it.stride;
    }
    auto branch = [&](int j, const bf16_t* pre, int Kj, const bf16_t* Wout) {
      f32x16 g[2][2]; acc_zero<2>(g);
      gemm_acc<2, 0>(g, P.hb + (long)mt * 128 * D, D, P.wb + O_WIN + C_GATE + j * 1024 + nt * 128, INW, D, smem);
      f32x16 y[2][2]; acc_zero<2>(y);
      gemm_acc<2, 0>(y, pre + (long)mt * 128 * Kj, Kj, Wout + nt * 128, 1024, Kj, smem);
      const float* bias = P.gate_bias + ((long)l * 4 + j) * 1024 + nt * 128;
      epi_each<2>([&](int mi, int nj, int i, int rl, int cl) {
        bf16_t* o = P.mixed + (unsigned)((mt * 128 + rl) * D + nt * 128 + cl);
        float v = sigmoidf_(g[mi][nj][i] + bias[cl]) * y[mi][nj][i];
        if (j > 0) v += bf2f(*o);
        *o = f2bf(v);
      });
    };
    if (MASK & 1) branch(0, P.preA, 256, P.wb + O_CONV);
    if (MASK & 2) branch(1, P.preB, 256, P.wb + O_RWKV);
    if (MASK & 4) branch(2, P.preC, 256, P.wb + O_MLA);
    if (MASK & 8) branch(3, P.Xc, 512, P.Wf + (long)l * 512 * 1024);
  }
}

DI void phase_resid_gemm(const Params& P, const bf16_t* A, int K, const bf16_t* W, const float* xsrc, lptr smem, int nb, int bid, volatile LAS unsigned* xs) {
  for (TileIt it = tile_it(xs, 8, nb, bid); it.j < it.count; it.j += it.stride) {
    int mt, nt; tile_get(it, 8, mt, nt);
    f32x16 acc[2][2]; acc_zero<2>(acc);
    gemm_acc<2, 0, 3>(acc, A + (long)mt * 128 * K, K, W + nt * 128, D, K, smem);
    epi_each<2>([&](int mi, int nj, int i, int rl, int cl) {
      const long o = (long)(mt * 128 + rl) * D + nt * 128 + cl;
      P.xres[o] = xsrc[o] + acc[mi][nj][i];
    });
  }
}

DI void phase_ffn_gu(const Params& P, int l, lptr smem, int nb, int bid, volatile LAS unsigned* xs) {
  const bf16_t* W = P.wb + O_GU;
  for (TileIt it = tile_it(xs, 22, nb, bid); it.j < it.count; it.j += it.stride) {
    int mt, nt; tile_get(it, 22, mt, nt);
    f32x16 g[2][2], u[2][2]; acc_zero<2>(g); acc_zero<2>(u);
    gemm_acc<2, 0>(g, P.hb + (long)mt * 128 * D, D, W + nt * 128, 2 * DFF, D, smem);
    gemm_acc<2, 0>(u, P.hb + (long)mt * 128 * D, D, W + DFF + nt * 128, 2 * DFF, D, smem);
    epi_each<2>([&](int mi, int nj, int i, int rl, int cl) {
      const float gv = g[mi][nj][i];
      P.hidden[(long)(mt * 128 + rl) * DFF + nt * 128 + cl] = f2bf(gv * sigmoidf_(gv) * u[mi][nj][i]);
    });
  }
}

template <int PH> DI void run_phase(const Params& P, int l, lptr smem, int nb, int bid, volatile LAS unsigned* xs) {
  if (PH == 0) { phase_prologue(P, nb, bid); }
  if (PH == 1) { phase_norm<false>(l == 0 ? P.x : P.xres, P.mix_norm + l * D, P.hb, nullptr, nb, bid); phase_cvt_weights(P, l, nb, bid); }
  if (PH == 2) phase_inproj(P, l, smem, nb, bid, xs);
  if (PH == 3) phase2(P, l, smem, nb, bid);
  if (PH == 4) phase3(P, l, smem, nb, bid);
  if (PH == 5) phase4(P, l, nb, bid);
  if (PH == 6) phase5<2>(P, l, smem, nb, bid, xs, nullptr);
  if (PH == 7) phase_resid_gemm(P, P.mixed, D, P.wb + O_WO, l == 0 ? P.x : P.xres, smem, nb, bid, xs);
  if (PH == 8) phase_norm<false>(P.xres, P.ffn_norm + l * D, P.hb, nullptr, nb, bid);
  if (PH == 9) phase_ffn_gu(P, l, smem, nb, bid, xs);
  if (PH == 10) phase_resid_gemm(P, P.hidden, DFF, P.wb + O_DOWN, P.xres, smem, nb, bid, xs);
  if (PH == 11) phase_norm<true>(P.xres, P.final_norm, nullptr, P.out, nb, bid);
}

#if !MULTI_LAUNCH
__global__ void __launch_bounds__(NTHR, 2) mega_kernel(Params P) {
  __shared__ __attribute__((aligned(16))) char smem_raw[SMEM_BYTES];
  lptr smem = (lptr)smem_raw;
  cg::grid_group grid = cg::this_grid();
  const int nb = gridDim.x, bid = blockIdx.x;
  unsigned bar_target = 0;
  __shared__ uint4 xb_words;
  volatile LAS unsigned* xst = (volatile LAS unsigned*)&xb_words;
  if (threadIdx.x == 0) xst[2] = bar_add(P.bar + 64 * (2 * NG + 1 + xcc_id()));
  run_phase<0>(P, 0, smem, nb, bid, xst);
  grid.sync();
  if (threadIdx.x == 0) {
    unsigned mine = 0, cnt = 0, dense = 0; const unsigned me = xcc_id();
    for (unsigned j = 0; j < 16; ++j) { const unsigned c = bar_ld(P.bar + 64 * (2 * NG + 1 + j)); cnt += c > 0u ? 1u : 0u; dense += (j < me && c > 0u) ? 1u : 0u; mine = j == me ? c : mine; }
    xst[0] = mine; xst[1] = cnt; xst[3] = dense | (cnt == 8u ? 0x100u : 0u);
  }
  __syncthreads();
#define GSYNC() { bar_target += 1u; grp_barrier(P.bar, bar_target, xst); }
#define RUNP(k) { run_phase<k>(P, l, smem, nb, bid, xst); GSYNC(); if (DUP_MASK & (1 << k)) { run_phase<k>(P, l, smem, nb, bid, xst); GSYNC(); } }
  for (int l = 0; l < NL; ++l) {
    RUNP(1) RUNP(2) RUNP(3) RUNP(4) RUNP(5) RUNP(6) RUNP(7) RUNP(8) RUNP(9) RUNP(10)
  }
  run_phase<11>(P, 0, smem, nb, bid, xst);
}
#else
template <int PH> __global__ void __launch_bounds__(NTHR, 2) phase_kernel(Params P, int l) {
  __shared__ __attribute__((aligned(16))) char smem_raw[SMEM_BYTES];
  run_phase<PH>(P, l, (lptr)smem_raw, gridDim.x, blockIdx.x, nullptr);
}
#endif

extern "C" void kernel_launch(void* const* d_in, const int* in_sizes, int n_in, void* d_out, int out_size, void* d_ws, size_t ws_size,
                              hipStream_t stream) {
  Params P{};
  P.x = (const float*)d_in[0]; P.pos = (const int*)d_in[1];
  const float** fp = &P.mix_norm;
  for (int i = 0; i < 28; ++i) fp[i] = (const float*)d_in[2 + i];
  P.out = (float*)d_out;
  char* ws = (char*)d_ws; size_t off = 0;
  auto take = [&](size_t bytes) { char* p = ws + off; off += (bytes + 255) & ~(size_t)255; return p; };
  P.xres = (float*)take((size_t)T * D * 4);
  P.hb = (bf16_t*)take((size_t)T * D * 2);
  P.mixed = (bf16_t*)take((size_t)T * D * 2);
  P.proj = (bf16_t*)take((size_t)T * PW * 2);
  P.preA = (bf16_t*)take((size_t)T * 256 * 2);
  P.preB = (bf16_t*)take((size_t)T * 256 * 2);
  P.preC = (bf16_t*)take((size_t)T * 256 * 2);
  P.hidden = P.proj;
  P.Xc = (bf16_t*)take((size_t)T * 512 * 2);
  P.fft1 = (bf16_t*)take((size_t)2 * 128 * 128 * 256 * 2);
  P.wb = (bf16_t*)take((size_t)WB_ELEMS * 2);
  P.Qb = (bf16_t*)take((size_t)T * 4 * 96 * 2);
  P.Kb = (bf16_t*)take((size_t)T * 4 * 96 * 2);
  P.Vt = (bf16_t*)take((size_t)T * 256 * 2);
  P.LW = (bf16_t*)take((size_t)2 * T * 256 * 2);
  P.AA = (bf16_t*)take((size_t)2 * T * 256 * 2);
  P.Gg = (bf16_t*)take((size_t)T * 256 * 2);
  P.YS = (float*)take((size_t)2 * T * 256 * 4);
  P.Wf = (bf16_t*)take((size_t)NL * 512 * 1024 * 2);
  P.ropeC = (float*)take((size_t)T * 16 * 4);
  P.ropeS = (float*)take((size_t)T * 16 * 4);
  P.tabC = (bf16_t*)take(128 * 128 * 2);
  P.tabMS = (bf16_t*)take(128 * 128 * 2);
  P.tabT2 = (bf16_t*)take(128 * 128 * 2);
  P.bar = (unsigned*)take(64 * (5 * NG + 3) * 4);
  for (int i = 0; i < 16; ++i) P.invf[i] = pow(10000.0, -(double)i / 16.0);
  if (off > ws_size) { fprintf(stderr, "workspace too small: need %zu have %zu\n", off, ws_size); return; }
#if !MULTI_LAUNCH
  static int grid_blocks = 0;
  if (!grid_blocks) {
    int dev = 0, cus = 0, per_cu = 0;
    hipGetDevice(&dev);
    hipDeviceGetAttribute(&cus, hipDeviceAttributeMultiprocessorCount, dev);
    hipOccupancyMaxActiveBlocksPerMultiprocessor(&per_cu, mega_kernel, NTHR, 0);
    if (per_cu > 2) per_cu = 2;
    grid_blocks = cus * per_cu;
  }
  (void)hipMemsetAsync(P.bar, 0, 64 * (5 * NG + 3) * 4, stream);
  void* args[] = {&P};
  hipError_t e = hipLaunchCooperativeKernel((void*)mega_kernel, dim3(grid_blocks), dim3(NTHR), args, 0, stream);
  if (e != hipSuccess) fprintf(stderr, "cooperative launch failed: %s (grid %d)\n", hipGetErrorString(e), grid_blocks);
#else
  const int G = 512;
  phase_kernel<0><<<G, NTHR, 0, stream>>>(P, 0);
  for (int l = 0; l < NL; ++l) {
    phase_kernel<1><<<G, NTHR, 0, stream>>>(P, l);
    phase_kernel<2><<<G, NTHR, 0, stream>>>(P, l);
    phase_kernel<3><<<G, NTHR, 0, stream>>>(P, l);
    phase_kernel<4><<<G, NTHR, 0, stream>>>(P, l);
    phase_kernel<5><<<G, NTHR, 0, stream>>>(P, l);
    phase_kernel<6><<<G, NTHR, 0, stream>>>(P, l);
    phase_kernel<7><<<G, NTHR, 0, stream>>>(P, l);
    phase_kernel<8><<<G, NTHR, 0, stream>>>(P, l);
    phase_kernel<9><<<G, NTHR, 0, stream>>>(P, l);
    phase_kernel<10><<<G, NTHR, 0, stream>>>(P, l);
  }
  phase_kernel<11><<<G, NTHR, 0, stream>>>(P, 0);
#endif
}
```

```cpp
#include <hip/hip_runtime.h>
#include <hip/hip_cooperative_groups.h>
#include <cstdio>
#include <cmath>
namespace cg = cooperative_groups;

#define DI __device__ __forceinline__
#ifndef USE_TR
#define USE_TR 1
#endif
#ifndef DUP_MASK
#define DUP_MASK 0
#endif
#ifndef MULTI_LAUNCH
#define MULTI_LAUNCH 0
#endif

typedef __attribute__((address_space(3))) char* lptr;
#define LAS __attribute__((address_space(3)))
typedef short bf16x8 __attribute__((ext_vector_type(8)));
typedef short s16x4 __attribute__((ext_vector_type(4)));
typedef short v4i16_t __attribute__((vector_size(8)));
typedef float f32x16 __attribute__((ext_vector_type(16)));
typedef float f32x4 __attribute__((ext_vector_type(4)));
typedef float f32x2 __attribute__((ext_vector_type(2)));
typedef __bf16 bf16x2_t __attribute__((ext_vector_type(2)));
typedef unsigned u32x4 __attribute__((ext_vector_type(4)));
typedef unsigned u32x2 __attribute__((ext_vector_type(2)));
typedef unsigned short bf16_t;

constexpr int T = 16384, S = 8192, D = 1024, NL = 4, INW = 6688, PW = 2592, DFF = 2816;
constexpr int C_CX = 0, C_CB = 256, C_CC = 512, C_R = 768, C_K = 1024, C_V = 1280, C_WLO = 1536, C_ALO = 1664, C_GLO = 1792,
              C_QLO = 1920, C_KVLO = 2176, C_FIN = 2336, C_GATE = 2592;
constexpr int NTHR = 256;
constexpr int O_WIN = 0, O_CONV = O_WIN + D * INW, O_RWKV = O_CONV + 256 * D, O_MLA = O_RWKV + 256 * D, O_WO = O_MLA + 256 * D,
              O_GU = O_WO + D * D, O_DOWN = O_GU + D * 2 * DFF, O_UQ = O_DOWN + DFF * D, O_UKV = O_UQ + 256 * 384, O_WUP = O_UKV + 128 * 512,
              O_AUP = O_WUP + 2 * 64 * 256, O_GUP = O_AUP + 2 * 64 * 256, WB_ELEMS = O_GUP + 128 * 256;
constexpr int SMEM_BYTES = 57344;

DI unsigned pk2(float a, float b) { f32x2 v = {a, b}; bf16x2_t r = __builtin_convertvector(v, bf16x2_t); return __builtin_bit_cast(unsigned, r); }
DI bf16_t f2bf(float x) { return (bf16_t)(pk2(x, 0.f) & 0xffffu); }
DI float bf2f(bf16_t v) { return __uint_as_float(((unsigned)v) << 16); }
DI float bflo(unsigned u) { return __uint_as_float(u << 16); }
DI float bfhi(unsigned u) { return __uint_as_float(u & 0xffff0000u); }
DI float wave_sum(float x) {
#pragma unroll
  for (int o = 32; o >= 1; o >>= 1) x += __shfl_xor(x, o);
  return x;
}
DI float sigmoidf_(float x) { return __builtin_amdgcn_rcpf(1.f + __expf(-x)); }
DI float tanhf_(float x) { float e = __expf(-2.f * fabsf(x)); float t = (1.f - e) * __builtin_amdgcn_rcpf(1.f + e); return x < 0.f ? -t : t; }
DI s16x4 trr(lptr p) { return __builtin_bit_cast(s16x4, __builtin_amdgcn_ds_read_tr16_b64_v4i16((LAS v4i16_t*)p)); }
DI int otid() { int t = threadIdx.x; asm volatile("" : "+v"(t)); return t; }
DI int crow(int i, int h) { return (i & 3) + 8 * (i >> 2) + 4 * h; }

struct Params {
  const float* x; const int* pos;
  const float *mix_norm, *w_in, *gate_bias, *conv_w, *conv_out, *rwkv_mu, *rwkv_w0, *rwkv_w_up, *rwkv_a0, *rwkv_a_up, *rwkv_g_up,
      *rwkv_k_k, *rwkv_k_a, *rwkv_r_k, *rwkv_ln_g, *rwkv_ln_b, *rwkv_out, *mla_q_norm, *mla_w_uq, *mla_kv_norm, *mla_w_ukv, *mla_out,
      *fnet_out, *w_o, *ffn_norm, *ffn_w_gu, *ffn_w_down, *final_norm;
  float* out;
  float* xres; bf16_t *hb, *mixed, *proj, *preA, *preB, *preC, *Xc, *hidden; bf16_t* fft1; bf16_t* wb;
  bf16_t *Qb, *Kb, *Vt, *LW, *AA, *Gg; float* YS; bf16_t* Wf; float *ropeC, *ropeS; bf16_t *tabC, *tabMS, *tabT2;
  unsigned* bar;
  double invf[16];
};

constexpr int SA_STRIDE = 144;
constexpr int SA_BYTES = 128 * SA_STRIDE;
constexpr int GEMM_SMEM = SA_BYTES + 64 * 320;

template <int ATR> DI unsigned atr2(unsigned u) {
  if (ATR == 0) return u;
  float a = bflo(u), b = bfhi(u);
  if (ATR == 1) { a = tanhf_(a); b = tanhf_(b); }
  if (ATR == 2) { a = sigmoidf_(a); b = sigmoidf_(b); }
  return pk2(a, b);
}

template <int WN, int ATR, int PD = 2>
DI void gemm_acc(f32x16 (&acc)[2][WN], const bf16_t* __restrict__ A, int lda, const bf16_t* __restrict__ B, int ldb, int K, lptr smem) {
  constexpr int BN = 64 * WN, SBS = BN * 2 + 64, CPR = 8 * WN, NB = 2 * WN, RPP = 256 / CPR;
  int tid_ = threadIdx.x; asm volatile("" : "+v"(tid_));
  const int tid = tid_, lane = tid & 63, w = tid >> 6, wm = w >> 1, wn = w & 1;
  const int r = lane & 31, h = lane >> 5;
  const int q = (lane & 15) >> 2, p = lane & 3, blk = (lane >> 4) & 1;
  lptr sA = smem, sB = smem + SA_BYTES;
  u32x4 ra0[4], ra1[4], ra2[4], rb0[NB], rb1[NB], rb2[NB];
  const int nk = K >> 6;
  const unsigned aoff = (unsigned)(((tid >> 3) * lda + (tid & 7) * 8) * 2), astep = (unsigned)(32 * lda * 2);
  const unsigned boff = (unsigned)(((tid / CPR) * ldb + (tid % CPR) * 8) * 2), bstep = (unsigned)(RPP * ldb * 2);
  const unsigned sao = (unsigned)((tid >> 3) * SA_STRIDE + (tid & 7) * 16), sbo = (unsigned)((tid / CPR) * SBS + (tid % CPR) * 16);
  const char* Ac = (const char*)A; const char* Bc = (const char*)B;
  const long bkstep = (long)ldb * 128;
  auto loadt = [&](u32x4 (&ra)[4], u32x4 (&rb)[NB], int kt) {
    const char* a = Ac + kt * 128; const char* b = Bc + kt * bkstep;
#pragma unroll
    for (int i = 0; i < 4; ++i) ra[i] = *(const u32x4*)(a + (aoff + i * astep));
#pragma unroll
    for (int i = 0; i < NB; ++i) rb[i] = *(const u32x4*)(b + (boff + i * bstep));
  };
  auto step = [&](u32x4 (&ra)[4], u32x4 (&rb)[NB], int kt) {
    __syncthreads();
#pragma unroll
    for (int i = 0; i < 4; ++i) {
      u32x4 v = ra[i];
      if (ATR != 0) { v.x = atr2<ATR>(v.x); v.y = atr2<ATR>(v.y); v.z = atr2<ATR>(v.z); v.w = atr2<ATR>(v.w); }
      *(LAS u32x4*)(sA + sao + i * 32 * SA_STRIDE) = v;
    }
#pragma unroll
    for (int i = 0; i < NB; ++i) *(LAS u32x4*)(sB + sbo + i * RPP * SBS) = rb[i];
    __syncthreads();
    loadt(ra, rb, kt + PD < nk ? kt + PD : nk - 1);
    lptr pa = sA + (wm * 64 + r) * SA_STRIDE + 16 * h;
    lptr pb = sB + (8 * h + q) * SBS + (wn * 32 * WN + 16 * blk + 4 * p) * 2;
#pragma unroll
    for (int s = 0; s < 4; ++s) {
      bf16x8 af[2];
#pragma unroll
      for (int mi = 0; mi < 2; ++mi) af[mi] = *(LAS bf16x8*)(pa + mi * 32 * SA_STRIDE + 32 * s);
#pragma unroll
      for (int nj = 0; nj < WN; ++nj) {
        s16x4 lo = trr(pb + 16 * s * SBS + nj * 64), hi = trr(pb + (16 * s + 4) * SBS + nj * 64);
        const bf16x8 bfr = __builtin_shufflevector(lo, hi, 0, 1, 2, 3, 4, 5, 6, 7);
#pragma unroll
        for (int mi = 0; mi < 2; ++mi) acc[mi][nj] = __builtin_amdgcn_mfma_f32_32x32x16_bf16(af[mi], bfr, acc[mi][nj], 0, 0, 0);
      }
    }
  };
  loadt(ra0, rb0, 0);
  __builtin_amdgcn_sched_barrier(0);
  loadt(ra1, rb1, nk > 1 ? 1 : 0);
  __builtin_amdgcn_sched_barrier(0);
  if (PD == 3) { loadt(ra2, rb2, nk > 2 ? 2 : nk - 1); __builtin_amdgcn_sched_barrier(0); }
  if (PD == 3) {
    int kt = 0;
#pragma unroll 1
    for (; kt + 2 < nk; kt += 3) { step(ra0, rb0, kt); step(ra1, rb1, kt + 1); step(ra2, rb2, kt + 2); }
    if (kt < nk) step(ra0, rb0, kt);
    if (kt + 1 < nk) step(ra1, rb1, kt + 1);
  } else {
#pragma unroll 1
    for (int kt = 0; kt < nk; kt += 2) {
      step(ra0, rb0, kt);
      if (kt + 1 < nk) step(ra1, rb1, kt + 1);
    }
  }
}

template <int WN> DI void acc_zero(f32x16 (&acc)[2][WN]) {
#pragma unroll
  for (int mi = 0; mi < 2; ++mi)
#pragma unroll
    for (int nj = 0; nj < WN; ++nj)
#pragma unroll
      for (int i = 0; i < 16; ++i) acc[mi][nj][i] = 0.f;
}
template <int WN, class F> DI void epi_each(F f) {
  int tid_ = threadIdx.x; asm volatile("" : "+v"(tid_));
  const int lane = tid_ & 63, w = tid_ >> 6, wm = w >> 1, wn = w & 1, r = lane & 31, h = lane >> 5;
#pragma unroll
  for (int mi = 0; mi < 2; ++mi)
#pragma unroll
    for (int nj = 0; nj < WN; ++nj)
#pragma unroll
      for (int i = 0; i < 16; ++i) f(mi, nj, i, wm * 64 + mi * 32 + crow(i, h), wn * 32 * WN + nj * 32 + r);
}

constexpr int NG = 16;
DI unsigned bar_ld(unsigned* p) { return __hip_atomic_load(p, __ATOMIC_RELAXED, __HIP_MEMORY_SCOPE_AGENT); }
DI unsigned bar_add(unsigned* p) { return __hip_atomic_fetch_add(p, 1u, __ATOMIC_RELAXED, __HIP_MEMORY_SCOPE_AGENT); }
DI unsigned xcc_id() { return (unsigned)__builtin_amdgcn_s_getreg((3 << 11) | 20) & 0xFu; }
DI void grp_barrier(unsigned* bar, unsigned k, volatile LAS unsigned* st) {
  asm volatile("s_waitcnt vmcnt(0) lgkmcnt(0)" ::: "memory");
  __syncthreads();
  if (threadIdx.x == 0) {
    const unsigned g = xcc_id(), gsize = st[0], ng = st[1];
    const unsigned old = bar_add(bar + 64 * g);
    if (old + 1u == k * gsize) {
      __builtin_amdgcn_fence(__ATOMIC_RELEASE, "agent");
      asm volatile("s_waitcnt vmcnt(0)" ::: "memory");
      (void)bar_add(bar + 64 * (2 * NG));
      while (bar_ld(bar + 64 * (2 * NG)) < k * ng) __builtin_amdgcn_s_sleep(1);
      __builtin_amdgcn_fence(__ATOMIC_ACQUIRE, "agent");
      (void)bar_add(bar + 64 * (NG + g));
      asm volatile("s_waitcnt vmcnt(0)" ::: "memory");
    } else {
      while (bar_ld(bar + 64 * (NG + g)) < k) __builtin_amdgcn_s_sleep(1);
      __builtin_amdgcn_fence(__ATOMIC_ACQUIRE, "agent");
      asm volatile("s_waitcnt vmcnt(0)" ::: "memory");
    }
  }
  __syncthreads();
}

DI void sub_barrier(unsigned* bar, unsigned k, unsigned r, unsigned n) {
  asm volatile("s_waitcnt vmcnt(0) lgkmcnt(0)" ::: "memory");
  __syncthreads();
  if (threadIdx.x == 0) {
    const unsigned g = r % NG, gsize = (n - g + NG - 1) / NG, ng = n < (unsigned)NG ? n : (unsigned)NG;
    __builtin_amdgcn_fence(__ATOMIC_RELEASE, "agent");
    asm volatile("s_waitcnt vmcnt(0)" ::: "memory");
    const unsigned old = bar_add(bar + 64 * g);
    if (old + 1u == k * gsize) {
      (void)bar_add(bar + 64 * (2 * NG));
      while (bar_ld(bar + 64 * (2 * NG)) < k * ng) __builtin_amdgcn_s_sleep(1);
      (void)bar_add(bar + 64 * (NG + g));
    } else {
      while (bar_ld(bar + 64 * (NG + g)) < k) __builtin_amdgcn_s_sleep(1);
    }
    __builtin_amdgcn_fence(__ATOMIC_ACQUIRE, "agent");
    asm volatile("s_waitcnt vmcnt(0)" ::: "memory");
  }
  __syncthreads();
}

struct TileIt { int j, stride, count, base, xmode; };
DI TileIt tile_it(volatile LAS unsigned* xs, int NT, int nb, int bid) {
  TileIt t; const unsigned info = xs ? xs[3] : 0u;
  if (info & 0x100u) { t.xmode = 1; t.j = (int)xs[2]; t.stride = (int)xs[0]; t.count = 16 * NT; t.base = (int)(info & 0xffu) * 16; }
  else { t.xmode = 0; t.j = bid; t.stride = nb; t.count = 128 * NT; t.base = 0; }
  return t;
}
DI void tile_get(const TileIt& t, int NT, int& mt, int& nt) { if (t.xmode) { mt = t.base + (t.j & 15); nt = t.j >> 4; } else { mt = t.j / NT; nt = t.j % NT; } }

DI float wave_sum_fast(float x);
template <bool OUTF32>
DI void phase_norm(const float* __restrict__ src, const float* __restrict__ gain, bf16_t* __restrict__ dstb, float* __restrict__ dstf, int nb, int bid) {
  const int tid0 = otid(); const int lane = tid0 & 63, w = tid0 >> 6;
  for (int row = bid * 4 + w; row < T; row += nb * 4) {
    const float* xr = src + (long)row * D;
    f32x4 v[4]; float ss = 0.f;
#pragma unroll
    for (int i = 0; i < 4; ++i) { v[i] = *(const f32x4*)(xr + i * 256 + lane * 4); ss += v[i].x * v[i].x + v[i].y * v[i].y + v[i].z * v[i].z + v[i].w * v[i].w; }
    ss = wave_sum_fast(ss);
    const float rinv = rsqrtf(ss * (1.f / D) + 1e-6f);
#pragma unroll
    for (int i = 0; i < 4; ++i) {
      const f32x4 g = *(const f32x4*)(gain + i * 256 + lane * 4);
      const float a = v[i].x * rinv * g.x, b = v[i].y * rinv * g.y, c = v[i].z * rinv * g.z, d = v[i].w * rinv * g.w;
      if (OUTF32) { f32x4 o = {a, b, c, d}; *(f32x4*)(dstf + (long)row * D + i * 256 + lane * 4) = o; }
      else { u32x2 o; o.x = pk2(a, b); o.y = pk2(c, d); *(u32x2*)(dstb + (long)row * D + i * 256 + lane * 4) = o; }
    }
  }
}

DI void cvt_seg(bf16_t* __restrict__ dst, const float* __restrict__ src, int n, int rowlen, const float* __restrict__ rscale, long gtid, long gn) {
  for (long e = gtid; e < (n >> 2); e += gn) {
    f32x4 v = *(const f32x4*)(src + e * 4);
    if (rscale) { const float sc = rscale[(int)((e * 4) / rowlen)]; v.x *= sc; v.y *= sc; v.z *= sc; v.w *= sc; }
    u32x2 o; o.x = pk2(v.x, v.y); o.y = pk2(v.z, v.w);
    *(u32x2*)(dst + e * 4) = o;
  }
}
DI void phase_cvt_weights(const Params& P, int l, int nb, int bid) {
  const long gtid = (long)bid * NTHR + otid(), gn = (long)nb * NTHR;
  cvt_seg(P.wb + O_WIN, P.w_in + (long)l * D * INW, D * INW, 1, nullptr, gtid, gn);
  cvt_seg(P.wb + O_CONV, P.conv_out + (long)l * 256 * D, 256 * D, 1, nullptr, gtid, gn);
  cvt_seg(P.wb + O_RWKV, P.rwkv_out + (long)l * 256 * D, 256 * D, 1, nullptr, gtid, gn);
  cvt_seg(P.wb + O_MLA, P.mla_out + (long)l * 256 * D, 256 * D, 1, nullptr, gtid, gn);
  cvt_seg(P.wb + O_WO, P.w_o + (long)l * D * D, D * D, 1, nullptr, gtid, gn);
  cvt_seg(P.wb + O_GU, P.ffn_w_gu + (long)l * D * 2 * DFF, D * 2 * DFF, 1, nullptr, gtid, gn);
  cvt_seg(P.wb + O_DOWN, P.ffn_w_down + (long)l * DFF * D, DFF * D, 1, nullptr, gtid, gn);
  cvt_seg(P.wb + O_UQ, P.mla_w_uq + (long)l * 256 * 384, 256 * 384, 384, P.mla_q_norm + l * 256, gtid, gn);
  cvt_seg(P.wb + O_UKV, P.mla_w_ukv + (long)l * 128 * 512, 128 * 512, 512, P.mla_kv_norm + l * 128, gtid, gn);
  cvt_seg(P.wb + O_WUP, P.rwkv_w_up + (long)l * 2 * 64 * 256, 2 * 64 * 256, 1, nullptr, gtid, gn);
  cvt_seg(P.wb + O_AUP, P.rwkv_a_up + (long)l * 2 * 64 * 256, 2 * 64 * 256, 1, nullptr, gtid, gn);
  cvt_seg(P.wb + O_GUP, P.rwkv_g_up + (long)l * 128 * 256, 128 * 256, 1, nullptr, gtid, gn);
}

DI void phase_prologue(const Params& P, int nb, int bid) {
  const long gtid = (long)bid * NTHR + otid(), gn = (long)nb * NTHR;
  for (long e = gtid; e < (long)T * 16; e += gn) {
    const int t = (int)(e >> 4), i = (int)(e & 15);
    const double rev = (double)P.pos[t] * P.invf[i] * 0.15915494309189535;
    const float fr = (float)(rev - floor(rev));
    P.ropeC[e] = __builtin_amdgcn_cosf(fr); P.ropeS[e] = __builtin_amdgcn_sinf(fr);
  }
  for (long e = gtid; e < 128 * 128; e += gn) {
    const int k1 = (int)(e >> 7), n1 = (int)(e & 127);
    const float fr = (float)((k1 * n1) & 127) * (1.f / 128.f);
    P.tabC[e] = f2bf(__builtin_amdgcn_cosf(fr)); P.tabMS[e] = f2bf(-__builtin_amdgcn_sinf(fr));
    const int part = k1 >> 6, k2 = k1 & 63, cpart = n1 >> 6, n2 = n1 & 63;
    const float f2 = (float)((k2 * n2) & 63) * (1.f / 64.f);
    const float c = __builtin_amdgcn_cosf(f2), s = __builtin_amdgcn_sinf(f2);
    float v = (part == 0) ? (cpart == 0 ? c : s) : (cpart == 0 ? -s : c);
    P.tabT2[e] = f2bf(v);
  }
  const float scl = 1.f / sqrtf((float)S * 64.f);
  for (long e = gtid; e < (long)NL * 512 * 1024; e += gn) {
    const int n = (int)(e & 1023), row = (int)((e >> 10) & 511), l = (int)(e >> 19);
    const int part = row >> 8, g = (row >> 6) & 3, c = row & 63;
    const float* wo = P.fnet_out + ((long)l * 256 + g * 64) * 1024 + n;
    float acc = 0.f;
    for (int c2 = 0; c2 < 64; ++c2) {
      const float fr = (float)((c * c2) & 63) * (1.f / 64.f);
      const float tv = part == 0 ? __builtin_amdgcn_cosf(fr) : __builtin_amdgcn_sinf(fr);
      acc += tv * wo[(long)c2 * 1024];
    }
    P.Wf[e] = f2bf(acc * scl);
  }
}

DI void phase_inproj(const Params& P, int l, lptr smem, int nb, int bid, volatile LAS unsigned* xs) {
  for (TileIt it = tile_it(xs, 21, nb, bid); it.j < it.count; it.j += it.stride) {
    int mt, nt; tile_get(it, 21, mt, nt);
    f32x16 acc[2][2]; acc_zero<2>(acc);
    gemm_acc<2, 0, 3>(acc, P.hb + (long)mt * 128 * D, D, P.wb + O_WIN + nt * 128, INW, D, smem);
    epi_each<2>([&](int mi, int nj, int i, int rl, int cl) {
      const int row = mt * 128 + rl, col = nt * 128 + cl; const float v = acc[mi][nj][i];
      if (col < PW) P.proj[(long)row * PW + col] = f2bf(v);
    });
  }
}

DI void job_conv(const Params& P, int l, int mt) {
  const float* cw = P.conv_w + (long)l * 3 * 256;
  for (int e = otid(); e < 128 * 256; e += NTHR) {
    const int t = mt * 128 + (e >> 8), c = e & 255, s = t & (S - 1);
    const bf16_t* pr = P.proj + (long)t * PW;
    const float z0 = bf2f(pr[C_CC + c]) * bf2f(pr[C_CX + c]);
    const float zm = s > 0 ? bf2f(pr[C_CC + c - PW]) * bf2f(pr[C_CX + c - PW]) : 0.f;
    const float zp = s < S - 1 ? bf2f(pr[C_CC + c + PW]) * bf2f(pr[C_CX + c + PW]) : 0.f;
    const float y = cw[c] * zm + cw[256 + c] * z0 + cw[512 + c] * zp;
    P.preA[(long)t * 256 + c] = f2bf(bf2f(pr[C_CB + c]) * y);
  }
}

DI void job_mla_prep(const Params& P, int l, int mt, int j, lptr smem) {
  const int tid = otid(), lane = tid & 63, w = tid >> 6;
  LAS float* sR = (LAS float*)(smem + GEMM_SMEM);
  __syncthreads();
  for (int rr = 0; rr < 32; ++rr) {
    const int rl = w * 32 + rr; const bf16_t* pr = P.proj + (long)(mt * 128 + rl) * PW;
    float ss;
    if (j < 3) { const u32x2 u = *(const u32x2*)(pr + C_QLO + lane * 4); const float a = bflo(u.x), b = bfhi(u.x), c = bflo(u.y), d = bfhi(u.y); ss = a * a + b * b + c * c + d * d; }
    else { const unsigned u = *(const unsigned*)(pr + C_KVLO + lane * 2); const float a = bflo(u), b = bfhi(u); ss = a * a + b * b; }
    ss = wave_sum(ss);
    if (lane == 0) sR[rl] = rsqrtf(ss * (j < 3 ? 1.f / 256.f : 1.f / 128.f) + 1e-6f);
  }
  f32x16 acc[2][2]; acc_zero<2>(acc);
  if (j < 3) {
    gemm_acc<2, 0>(acc, P.proj + (long)mt * 128 * PW + C_QLO, PW, P.wb + O_UQ + j * 128, 384, 256, smem);
    const float qs = 0.10206207261596577f * 1.4426950408889634f;
    epi_each<2>([&](int mi, int nj, int i, int rl, int cl) {
      const int t = mt * 128 + rl, col = j * 128 + cl, hh = col / 96, d = col - hh * 96;
      float v = acc[mi][nj][i] * sR[rl] * qs;
      const float pv = __shfl_xor(v, 16);
      if (d >= 64) {
        const float c = P.ropeC[t * 16 + (col & 15)], s = P.ropeS[t * 16 + (col & 15)];
        v = (col & 16) ? (v * c + pv * s) : (v * c - pv * s);
      }
      const int b = t >> 13, sq = t & (S - 1);
      P.Qb[((long)(b * 4 + hh) * S + sq) * 96 + d] = f2bf(v);
    });
  } else {
    const int hh = j - 3;
    gemm_acc<2, 0>(acc, P.proj + (long)mt * 128 * PW + C_KVLO, PW, P.wb + O_UKV + hh * 128, 512, 128, smem);
    const int wn = w & 1, wm = w >> 1, r = lane & 31, h = lane >> 5;
    const int b = (mt * 128) >> 13;
    if (wn == 0) {
      epi_each<2>([&](int mi, int nj, int i, int rl, int cl) {
        const int t = mt * 128 + rl, sq = t & (S - 1);
        P.Kb[((long)(b * 4 + hh) * S + sq) * 96 + cl] = f2bf(acc[mi][nj][i] * sR[rl]);
      });
    } else {
#pragma unroll
      for (int mi = 0; mi < 2; ++mi)
#pragma unroll
        for (int nj = 0; nj < 2; ++nj)
#pragma unroll
          for (int i4 = 0; i4 < 4; ++i4) {
            const int rl = wm * 64 + mi * 32 + 8 * i4 + 4 * h, dv = nj * 32 + r;
            const int sq = (mt * 128 + rl) & (S - 1);
            u32x2 o; o.x = pk2(acc[mi][nj][4 * i4] * sR[rl], acc[mi][nj][4 * i4 + 1] * sR[rl + 1]);
            o.y = pk2(acc[mi][nj][4 * i4 + 2] * sR[rl + 2], acc[mi][nj][4 * i4 + 3] * sR[rl + 3]);
            *(u32x2*)(P.Vt + ((long)(b * 4 + hh) * 64 + dv) * S + sq) = o;
          }
    }
    for (int e = tid; e < 128 * 16; e += NTHR) {
      const int t = mt * 128 + (e >> 4), i = e & 15, sq = t & (S - 1);
      const bf16_t* pr = P.proj + (long)t * PW + C_KVLO + 128;
      const float x1 = bf2f(pr[i]), x2 = bf2f(pr[16 + i]), c = P.ropeC[t * 16 + i], s = P.ropeS[t * 16 + i];
      bf16_t* kd = P.Kb + ((long)(b * 4 + hh) * S + sq) * 96 + 64;
      kd[i] = f2bf(x1 * c - x2 * s); kd[16 + i] = f2bf(x2 * c + x1 * s);
    }
  }
}

DI void job_rwkv_prep(const Params& P, int l, int mt, int which, int nt, lptr smem) {
  f32x16 acc[2][2]; acc_zero<2>(acc);
  const bf16_t* Ab = P.proj + (long)mt * 128 * PW;
  if (which < 2) {
    const int d = which;
    gemm_acc<2, 1>(acc, Ab + C_WLO + d * 64, PW, P.wb + O_WUP + d * 64 * 256 + nt * 128, 256, 64, smem);
    const float* w0 = P.rwkv_w0 + (l * 2 + d) * 256;
    epi_each<2>([&](int mi, int nj, int i, int rl, int cl) {
      const int t = mt * 128 + rl, col = nt * 128 + cl;
      const float z = acc[mi][nj][i] + w0[col];
      const float u = -z; const float sp = fmaxf(u, 0.f) + __logf(1.f + __expf(-fabsf(u)));
      const float wl = -sp - 0.5f;
      P.LW[((long)d * T + t) * 256 + col] = f2bf(-__expf(wl));
    });
  } else if (which < 4) {
    const int d = which - 2;
    gemm_acc<2, 0>(acc, Ab + C_ALO + d * 64, PW, P.wb + O_AUP + d * 64 * 256 + nt * 128, 256, 64, smem);
    const float* a0 = P.rwkv_a0 + (l * 2 + d) * 256;
    epi_each<2>([&](int mi, int nj, int i, int rl, int cl) {
      const int t = mt * 128 + rl, col = nt * 128 + cl;
      P.AA[((long)d * T + t) * 256 + col] = f2bf(sigmoidf_(acc[mi][nj][i] + a0[col]));
    });
  } else {
    gemm_acc<2, 2>(acc, Ab + C_GLO, PW, P.wb + O_GUP + nt * 128, 256, 128, smem);
    epi_each<2>([&](int mi, int nj, int i, int rl, int cl) {
      const int t = mt * 128 + rl, col = nt * 128 + cl;
      P.Gg[(long)t * 256 + col] = f2bf(acc[mi][nj][i]);
    });
  }
}

DI void job_fft1(const Params& P, int b, int n2, int nt, lptr smem) {
  f32x16 are[2][1], aim[2][1]; acc_zero<1>(are); acc_zero<1>(aim);
  const bf16_t* Bp = P.proj + ((long)(b * S + n2)) * PW + C_FIN + nt * 64;
  gemm_acc<1, 0>(are, P.tabC, 128, Bp, 64 * PW, 128, smem);
  gemm_acc<1, 0>(aim, P.tabMS, 128, Bp, 64 * PW, 128, smem);
  epi_each<1>([&](int mi, int nj, int i, int rl, int cl) {
    const int k1 = rl, col = nt * 64 + cl;
    const float fr = (float)((n2 * k1) & 8191) * (1.f / 8192.f);
    const float c = __builtin_amdgcn_cosf(fr), s = __builtin_amdgcn_sinf(fr);
    const float re = are[mi][nj][i], im = aim[mi][nj][i];
    bf16_t* o = P.fft1 + (((long)(b * 128 + k1) * 128) + n2) * 256 + col;
    o[0] = f2bf(re * c + im * s); o[64 * 256] = f2bf(im * c - re * s);
  });
}

DI void phase2(const Params& P, int l, lptr smem, int nb, int bid) {
  for (int job = bid; job < 1280; job += nb) job_rwkv_prep(P, l, job / 10, (job % 10) >> 1, job & 1, smem);
}

#define LDS_SYNC() { asm volatile("s_waitcnt lgkmcnt(0)" ::: "memory"); __syncthreads(); }
DI float dpp_xor1(float x) { return __int_as_float(__builtin_amdgcn_mov_dpp(__float_as_int(x), 0xB1, 0xF, 0xF, true)); }
DI float dpp_xor2(float x) { return __int_as_float(__builtin_amdgcn_mov_dpp(__float_as_int(x), 0x4E, 0xF, 0xF, true)); }

DI float dpp_ror4(float x) { return __int_as_float(__builtin_amdgcn_mov_dpp(__float_as_int(x), 0x124, 0xF, 0xF, true)); }
DI float dpp_ror8(float x) { return __int_as_float(__builtin_amdgcn_mov_dpp(__float_as_int(x), 0x128, 0xF, 0xF, true)); }
DI float row16_sum(float x) { x += dpp_xor1(x); x += dpp_xor2(x); x += dpp_ror4(x); x += dpp_ror8(x); return x; }
DI float rdl(float x, int l) { return __int_as_float(__builtin_amdgcn_readlane(__float_as_int(x), l)); }
DI float wave_sum_fast(float x) { x = row16_sum(x); return (rdl(x, 0) + rdl(x, 16)) + (rdl(x, 32) + rdl(x, 48)); }

struct ScanRaw { bf16_t r[9], k[9], v[9], lw[8], aa[8]; };
constexpr int SCB = 6400;
DI void job_scan(const Params& P, int l, int job, lptr smem) {
  const int chain = job >> 3, v0 = (job & 7) * 8;
  const int d = chain >> 3, b = (chain >> 2) & 1, hh = chain & 3;
  const int tid = otid(), lane = tid & 63, w = tid >> 6;
  LAS float* sbase = (LAS float*)smem;
  if (w >= 2) {
    const int pw = w - 2, ptid = tid - 128;
    const int gc = hh * 64 + lane;
    const float mu_r = P.rwkv_mu[((l * 2 + d) * 3 + 0) * 256 + gc], mu_k = P.rwkv_mu[((l * 2 + d) * 3 + 1) * 256 + gc], mu_v = P.rwkv_mu[((l * 2 + d) * 3 + 2) * 256 + gc];
    const float kkc = P.rwkv_k_k[l * 256 + gc], kac = P.rwkv_k_a[l * 256 + gc];
    ScanRaw raw;
    auto load_raw = [&](int chunk) {
#pragma unroll
      for (int e = 0; e < 9; ++e) {
        const int tau = chunk * 16 + pw * 8 + e - 1;
        const int tc = tau < 0 ? 0 : tau, s = d == 0 ? tc : S - 1 - tc;
        const bf16_t* pr = P.proj + (long)(b * S + s) * PW;
        raw.r[e] = pr[C_R + gc]; raw.k[e] = pr[C_K + gc]; raw.v[e] = pr[C_V + gc];
        if (e > 0) { raw.lw[e - 1] = P.LW[((long)d * T + b * S + s) * 256 + gc]; raw.aa[e - 1] = P.AA[((long)d * T + b * S + s) * 256 + gc]; }
      }
    };
    auto prep = [&](int chunk) {
      LAS float* B = sbase + (chunk & 1) * SCB;
      const bool first = (chunk == 0 && pw == 0);
      float rp = first ? 0.f : bf2f(raw.r[0]), kp = first ? 0.f : bf2f(raw.k[0]), vp = first ? 0.f : bf2f(raw.v[0]);
#pragma unroll
      for (int e = 0; e < 8; ++e) {
        const int i = pw * 8 + e;
        const float r0 = bf2f(raw.r[e + 1]), k0 = bf2f(raw.k[e + 1]), vv0 = bf2f(raw.v[e + 1]);
        const float rd = r0 + mu_r * (rp - r0), kd = k0 + mu_k * (kp - k0), vd = vv0 + mu_v * (vp - vv0);
        rp = r0; kp = k0; vp = vv0;
        const float lw = bf2f(raw.lw[e]), aa = bf2f(raw.aa[e]);
        const float pk_ = kd * kkc, kt = kd * (1.f + (aa - 1.f) * kac);
        const float ss = wave_sum_fast(pk_ * pk_);
        const float inv = __builtin_amdgcn_rsqf(fmaxf(ss, 1e-24f));
        const float kk = pk_ * inv, wd = __expf(lw);
        B[i * 64 + lane] = rd; B[1024 + i * 64 + lane] = wd; B[2048 + i * 64 + lane] = kt;
        B[3072 + i * 64 + lane] = kk; B[4096 + i * 64 + lane] = kk * aa; B[5120 + i * 64 + lane] = vd;
      }
    };
    load_raw(0);
    prep(0);
    load_raw(1);
    for (int c = 0; c <= 512; ++c) {
      LDS_SYNC();
      if (c > 0) {
        const int i = ptid >> 3, cc = ptid & 7;
        const int tau = (c - 1) * 16 + i, s = d == 0 ? tau : S - 1 - tau;
        P.YS[((long)d * T + b * S + s) * 256 + hh * 64 + v0 + cc] = sbase[((c - 1) & 1) * SCB + 6176 + i * 8 + cc];
      }
      if (c < 511) { prep(c + 1); load_raw(c + 2 < 512 ? c + 2 : 511); }
    }
  } else {
    const int vr = w * 4 + (lane >> 4), kq = lane & 15;
    f32x4 st = {0.f, 0.f, 0.f, 0.f};
    for (int c = 0; c <= 512; ++c) {
      LDS_SYNC();
      if (c < 512) {
        LAS float* B = sbase + (c & 1) * SCB;
        LAS float* sRD = B; LAS float* sW = B + 1024; LAS float* sKT = B + 2048; LAS float* sKK = B + 3072; LAS float* sBB = B + 4096; LAS float* sV = B + 5120;
        LAS float* sY = B + 6176;
        f32x4 kk4 = *(LAS f32x4*)(sKK + kq * 4), rd4 = *(LAS f32x4*)(sRD + kq * 4), w4 = *(LAS f32x4*)(sW + kq * 4), b4 = *(LAS f32x4*)(sBB + kq * 4), kt4 = *(LAS f32x4*)(sKT + kq * 4);
        float vv = sV[v0 + vr];
        float ykeep = 0.f;
        float ypend = 0.f;
#pragma unroll
        for (int i = 0; i < 16; ++i) {
          const int in = (i + 1) & 15, o = in * 64 + kq * 4;
          const f32x4 nkk4 = *(LAS f32x4*)(sKK + o), nrd4 = *(LAS f32x4*)(sRD + o), nw4 = *(LAS f32x4*)(sW + o), nb4 = *(LAS f32x4*)(sBB + o), nkt4 = *(LAS f32x4*)(sKT + o);
          const float nvv = sV[in * 64 + v0 + vr];
          float sa = (st.x * kk4.x + st.y * kk4.y) + (st.z * kk4.z + st.w * kk4.w);
          float yp = ypend;
          sa += dpp_xor1(sa); yp += dpp_xor1(yp); sa += dpp_xor2(sa); yp += dpp_xor2(yp);
          sa += dpp_ror4(sa); yp += dpp_ror4(yp); sa += dpp_ror8(sa); yp += dpp_ror8(yp);
          if (i > 0) ykeep = kq == i - 1 ? yp : ykeep;
          st.x = st.x * w4.x - sa * b4.x + vv * kt4.x; st.y = st.y * w4.y - sa * b4.y + vv * kt4.y;
          st.z = st.z * w4.z - sa * b4.z + vv * kt4.z; st.w = st.w * w4.w - sa * b4.w + vv * kt4.w;
          ypend = (st.x * rd4.x + st.y * rd4.y) + (st.z * rd4.z + st.w * rd4.w);
          kk4 = nkk4; rd4 = nrd4; w4 = nw4; b4 = nb4; kt4 = nkt4; vv = nvv;
        }
        { const float yp = row16_sum(ypend); ykeep = kq == 15 ? yp : ykeep; }
        sY[kq * 8 + vr] = ykeep;
      }
    }
  }
}

constexpr int SK_STRIDE = 208, SV_STRIDE = 144;
DI void job_attn(const Params& P, int job, lptr smem) {
  const int bh = job >> 6, qb = job & 63, q0 = qb * 128;
  const int tid = otid(), lane = tid & 63, w = tid >> 6, r = lane & 31, h = lane >> 5;
  lptr sK = smem, sV = smem + 64 * SK_STRIDE;
  const bf16_t* Kg = P.Kb + (long)bh * S * 96; const bf16_t* Vg = P.Vt + (long)bh * 64 * S;
  bf16x8 qf[6];
  { const bf16_t* qp = P.Qb + ((long)bh * S + q0 + w * 32 + r) * 96 + 8 * h;
#pragma unroll
    for (int s = 0; s < 6; ++s) qf[s] = *(const bf16x8*)(qp + 16 * s); }
  f32x16 O[2];
#pragma unroll
  for (int i = 0; i < 16; ++i) { O[0][i] = 0.f; O[1][i] = 0.f; }
  float m = -1e30f, lsum = 0.f;
  u32x4 rk[3], rv[2];
#pragma unroll
  for (int i = 0; i < 3; ++i) { const int c = tid + 256 * i; rk[i] = *(const u32x4*)(Kg + (long)(c / 12) * 96 + (c % 12) * 8); }
#pragma unroll
  for (int i = 0; i < 2; ++i) { const int c = tid + 256 * i; rv[i] = *(const u32x4*)(Vg + (long)(c >> 3) * S + (c & 7) * 8); }
  for (int kt = 0; kt < 128; ++kt) {
    __syncthreads();
#pragma unroll
    for (int i = 0; i < 3; ++i) { const int c = tid + 256 * i; *(LAS u32x4*)(sK + (c / 12) * SK_STRIDE + (c % 12) * 16) = rk[i]; }
#pragma unroll
    for (int i = 0; i < 2; ++i) { const int c = tid + 256 * i; *(LAS u32x4*)(sV + (c >> 3) * SV_STRIDE + (c & 7) * 16) = rv[i]; }
    __syncthreads();
    if (kt + 1 < 128) {
      const int k0 = (kt + 1) * 64;
#pragma unroll
      for (int i = 0; i < 3; ++i) { const int c = tid + 256 * i; rk[i] = *(const u32x4*)(Kg + (long)(k0 + c / 12) * 96 + (c % 12) * 8); }
#pragma unroll
      for (int i = 0; i < 2; ++i) { const int c = tid + 256 * i; rv[i] = *(const u32x4*)(Vg + (long)(c >> 3) * S + k0 + (c & 7) * 8); }
    }
    f32x16 sc[2];
#pragma unroll
    for (int ks = 0; ks < 2; ++ks) {
#pragma unroll
      for (int i = 0; i < 16; ++i) sc[ks][i] = 0.f;
#pragma unroll
      for (int s = 0; s < 6; ++s) {
        const bf16x8 kf = *(LAS bf16x8*)(sK + (ks * 32 + r) * SK_STRIDE + (16 * s + 8 * h) * 2);
        sc[ks] = __builtin_amdgcn_mfma_f32_32x32x16_bf16(kf, qf[s], sc[ks], 0, 0, 0);
      }
    }
    float mx = sc[0][0];
#pragma unroll
    for (int i = 0; i < 16; ++i) { mx = fmaxf(mx, sc[0][i]); mx = fmaxf(mx, sc[1][i]); }
    mx = fmaxf(mx, __shfl_xor(mx, 32));
    const float mn = fmaxf(m, mx), alpha = __builtin_amdgcn_exp2f(m - mn);
    m = mn;
    float rs = 0.f;
#pragma unroll
    for (int ks = 0; ks < 2; ++ks)
#pragma unroll
      for (int i = 0; i < 16; ++i) { const float pe = __builtin_amdgcn_exp2f(sc[ks][i] - mn); sc[ks][i] = pe; rs += pe; }
    lsum = lsum * alpha + rs;
#pragma unroll
    for (int i = 0; i < 16; ++i) { O[0][i] *= alpha; O[1][i] *= alpha; }
#pragma unroll
    for (int ks = 0; ks < 2; ++ks)
#pragma unroll
      for (int s2 = 0; s2 < 2; ++s2) {
        u32x4 pw; pw.x = pk2(sc[ks][8 * s2], sc[ks][8 * s2 + 1]); pw.y = pk2(sc[ks][8 * s2 + 2], sc[ks][8 * s2 + 3]);
        pw.z = pk2(sc[ks][8 * s2 + 4], sc[ks][8 * s2 + 5]); pw.w = pk2(sc[ks][8 * s2 + 6], sc[ks][8 * s2 + 7]);
        const bf16x8 pf = __builtin_bit_cast(bf16x8, pw);
        const int kb = ks * 32 + 16 * s2;
#pragma unroll
        for (int dvt = 0; dvt < 2; ++dvt) {
          lptr vp = sV + (dvt * 32 + r) * SV_STRIDE + (kb + 4 * h) * 2;
          const s16x4 lo = *(LAS s16x4*)vp, hi = *(LAS s16x4*)(vp + 16);
          const bf16x8 vf = __builtin_shufflevector(lo, hi, 0, 1, 2, 3, 4, 5, 6, 7);
          O[dvt] = __builtin_amdgcn_mfma_f32_32x32x16_bf16(vf, pf, O[dvt], 0, 0, 0);
        }
      }
  }
  lsum += __shfl_xor(lsum, 32);
  const float inv = 1.f / lsum;
  const int b = bh >> 2, hh = bh & 3;
  bf16_t* op = P.preC + ((long)(b * S + q0 + w * 32 + r)) * 256 + hh * 64;
#pragma unroll
  for (int dvt = 0; dvt < 2; ++dvt)
#pragma unroll
    for (int i4 = 0; i4 < 4; ++i4) {
      u32x2 o; o.x = pk2(O[dvt][4 * i4] * inv, O[dvt][4 * i4 + 1] * inv); o.y = pk2(O[dvt][4 * i4 + 2] * inv, O[dvt][4 * i4 + 3] * inv);
      *(u32x2*)(op + dvt * 32 + 8 * i4 + 4 * h) = o;
    }
}

DI void job_fft2(const Params& P, int b, int k1, int nt, lptr smem) {
  f32x16 acc[2][2]; acc_zero<2>(acc);
  gemm_acc<2, 0>(acc, P.tabT2, 128, P.fft1 + ((long)(b * 128 + k1) * 128) * 256 + nt * 128, 256, 128, smem);
  epi_each<2>([&](int mi, int nj, int i, int rl, int cl) {
    const int part = rl >> 6, k2 = rl & 63, s = k1 + 128 * k2;
    P.Xc[((long)(b * S + s)) * 512 + part * 256 + nt * 128 + cl] = f2bf(acc[mi][nj][i]);
  });
}

template <int MASK> DI void phase5(const Params& P, int l, lptr smem, int nb, int bid, volatile LAS unsigned* xs, unsigned* dynctr);
DI void phase3(const Params& P, int l, lptr smem, int nb, int bid) {
  if (bid < 128) { __builtin_amdgcn_s_setprio(3); job_scan(P, l, bid, smem); __builtin_amdgcn_s_setprio(0); return; }
  const int r = bid - 128, n = nb - 128;
  for (int job = r; job < 128 + 896 + 512; job += n) {
    if (job < 128) job_conv(P, l, job);
    else if (job < 1024) { const int e = job - 128; job_mla_prep(P, l, e / 7, e % 7, smem); }
    else { const int e = job - 1024; job_fft1(P, e >> 8, (e >> 2) & 63, e & 3, smem); }
  }
  sub_barrier(P.bar + 64 * (3 * NG + 1), (unsigned)(2 * l + 1), (unsigned)r, (unsigned)n);
  for (int job = r; job < 512 + 512; job += n) {
    if (job < 512) job_attn(P, job, smem);
    else { const int e = job - 512; job_fft2(P, e >> 8, (e >> 1) & 127, e & 1, smem); }
  }
  phase5<1>(P, l, smem, n, r, nullptr, P.bar + 64 * (5 * NG + 2) + l);
  sub_barrier(P.bar + 64 * (3 * NG + 1), (unsigned)(2 * l + 2), (unsigned)r, (unsigned)n);
  phase5<4 | 8>(P, l, smem, n, r, nullptr, nullptr);
}

DI void phase4(const Params& P, int l, int nb, int bid) {
  const int tid0 = otid(); const int lane = tid0 & 63, hh = tid0 >> 6, gc = hh * 64 + lane;
  const float lng = P.rwkv_ln_g[l * 256 + gc], lnb = P.rwkv_ln_b[l * 256 + gc], rk = P.rwkv_r_k[l * 256 + gc], kac = P.rwkv_k_a[l * 256 + gc];
  float mu[2][3];
#pragma unroll
  for (int d = 0; d < 2; ++d)
#pragma unroll
    for (int i = 0; i < 3; ++i) mu[d][i] = P.rwkv_mu[((l * 2 + d) * 3 + i) * 256 + gc];
  for (int t = bid; t < T; t += nb) {
    const int s = t & (S - 1);
    const float y = P.YS[(long)t * 256 + gc] + P.YS[((long)T + t) * 256 + gc];
    const float mean = wave_sum_fast(y) * (1.f / 64.f); const float dy = y - mean;
    const float var = wave_sum_fast(dy * dy) * (1.f / 64.f);
    const float yn = dy * rsqrtf(var + 64e-5f) * lng + lnb;
    const bf16_t* pr = P.proj + (long)t * PW;
    const float r0 = bf2f(pr[C_R + gc]), k0 = bf2f(pr[C_K + gc]), v0 = bf2f(pr[C_V + gc]);
    float bonus = 0.f;
#pragma unroll
    for (int d = 0; d < 2; ++d) {
      const bool valid = d == 0 ? (s > 0) : (s < S - 1);
      const bf16_t* pn = d == 0 ? pr - PW : pr + PW;
      const float rn = valid ? bf2f(pn[C_R + gc]) : 0.f, kn = valid ? bf2f(pn[C_K + gc]) : 0.f, vn = valid ? bf2f(pn[C_V + gc]) : 0.f;
      const float rd = r0 + mu[d][0] * (rn - r0), kd = k0 + mu[d][1] * (kn - k0), vd = v0 + mu[d][2] * (vn - v0);
      const float aa = bf2f(P.AA[((long)d * T + t) * 256 + gc]);
      const float kt = kd * (1.f + (aa - 1.f) * kac);
      bonus += wave_sum_fast(rd * kt * rk) * vd;
    }
    P.preB[(long)t * 256 + gc] = f2bf((yn + bonus) * bf2f(P.Gg[(long)t * 256 + gc]));
  }
}

template <int MASK>
DI void phase5(const Params& P, int l, lptr smem, int nb, int bid, volatile LAS unsigned* xs, unsigned* dynctr) {
  LAS int* sj = (LAS int*)(smem + 40960);
  TileIt it = tile_it(xs, 8, nb, bid);
  for (;;) {
    int mt, nt;
    if (dynctr) {
      __syncthreads();
      if (threadIdx.x == 0) *sj = (int)__hip_atomic_fetch_add(dynctr, 1u, __ATOMIC_RELAXED, __HIP_MEMORY_SCOPE_AGENT);
      __syncthreads();
      const int tile = *sj; if (tile >= 1024) break;
      mt = tile >> 3; nt = tile & 7;
    } else {
      if (it.j >= it.count) break;
      tile_get(it, 8, mt, nt); it.j += it.stride;
    }
    auto branch = [&](int j, const bf16_t* pre, int Kj, const bf16_t* Wout) {
      f32x16 g[2][2]; acc_zero<2>(g);
      gemm_acc<2, 0>(g, P.hb + (long)mt * 128 * D, D, P.wb + O_WIN + C_GATE + j * 1024 + nt * 128, INW, D, smem);
      f32x16 y[2][2]; acc_zero<2>(y);
      gemm_acc<2, 0>(y, pre + (long)mt * 128 * Kj, Kj, Wout + nt * 128, 1024, Kj, smem);
      const float* bias = P.gate_bias + ((long)l * 4 + j) * 1024 + nt * 128;
      epi_each<2>([&](int mi, int nj, int i, int rl, int cl) {
        bf16_t* o = P.mixed + (unsigned)((mt * 128 + rl) * D + nt * 128 + cl);
        float v = sigmoidf_(g[mi][nj][i] + bias[cl]) * y[mi][nj][i];
        if (j > 0) v += bf2f(*o);
        *o = f2bf(v);
      });
    };
    if (MASK & 1) branch(0, P.preA, 256, P.wb + O_CONV);
    if (MASK & 2) branch(1, P.preB, 256, P.wb + O_RWKV);
    if (MASK & 4) branch(2, P.preC, 256, P.wb + O_MLA);
    if (MASK & 8) branch(3, P.Xc, 512, P.Wf + (long)l * 512 * 1024);
  }
}

DI void phase_resid_gemm(const Params& P, const bf16_t* A, int K, const bf16_t* W, const float* xsrc, lptr smem, int nb, int bid, volatile LAS unsigned* xs) {
  for (TileIt it = tile_it(xs, 8, nb, bid); it.j < it.count; it.j += it.stride) {
    int mt, nt; tile_get(it, 8, mt, nt);
    f32x16 acc[2][2]; acc_zero<2>(acc);
    gemm_acc<2, 0, 3>(acc, A + (long)mt * 128 * K, K, W + nt * 128, D, K, smem);
    epi_each<2>([&](int mi, int nj, int i, int rl, int cl) {
      const long o = (long)(mt * 128 + rl) * D + nt * 128 + cl;
      P.xres[o] = xsrc[o] + acc[mi][nj][i];
    });
  }
}

DI void phase_ffn_gu(const Params& P, int l, lptr smem, int nb, int bid, volatile LAS unsigned* xs) {
  const bf16_t* W = P.wb + O_GU;
  for (TileIt it = tile_it(xs, 22, nb, bid); it.j < it.count; it.j += it.stride) {
    int mt, nt; tile_get(it, 22, mt, nt);
    f32x16 g[2][2], u[2][2]; acc_zero<2>(g); acc_zero<2>(u);
    gemm_acc<2, 0>(g, P.hb + (long)mt * 128 * D, D, W + nt * 128, 2 * DFF, D, smem);
    gemm_acc<2, 0>(u, P.hb + (long)mt * 128 * D, D, W + DFF + nt * 128, 2 * DFF, D, smem);
    epi_each<2>([&](int mi, int nj, int i, int rl, int cl) {
      const float gv = g[mi][nj][i];
      P.hidden[(long)(mt * 128 + rl) * DFF + nt * 128 + cl] = f2bf(gv * sigmoidf_(gv) * u[mi][nj][i]);
    });
  }
}

template <int PH> DI void run_phase(const Params& P, int l, lptr smem, int nb, int bid, volatile LAS unsigned* xs) {
  if (PH == 0) { phase_prologue(P, nb, bid); }
  if (PH == 1) { phase_norm<false>(l == 0 ? P.x : P.xres, P.mix_norm + l * D, P.hb, nullptr, nb, bid); phase_cvt_weights(P, l, nb, bid); }
  if (PH == 2) phase_inproj(P, l, smem, nb, bid, xs);
  if (PH == 3) phase2(P, l, smem, nb, bid);
  if (PH == 4) phase3(P, l, smem, nb, bid);
  if (PH == 5) phase4(P, l, nb, bid);
  if (PH == 6) phase5<2>(P, l, smem, nb, bid, xs, nullptr);
  if (PH == 7) phase_resid_gemm(P, P.mixed, D, P.wb + O_WO, l == 0 ? P.x : P.xres, smem, nb, bid, xs);
  if (PH == 8) phase_norm<false>(P.xres, P.ffn_norm + l * D, P.hb, nullptr, nb, bid);
  if (PH == 9) phase_ffn_gu(P, l, smem, nb, bid, xs);
  if (PH == 10) phase_resid_gemm(P, P.hidden, DFF, P.wb + O_DOWN, P.xres, smem, nb, bid, xs);
  if (PH == 11) phase_norm<true>(P.xres, P.final_norm, nullptr, P.out, nb, bid);
}

#if !MULTI_LAUNCH
__global__ void __launch_bounds__(NTHR, 2) mega_kernel(Params P) {
  __shared__ __attribute__((aligned(16))) char smem_raw[SMEM_BYTES];
  lptr smem = (lptr)smem_raw;
  cg::grid_group grid = cg::this_grid();
  const int nb = gridDim.x, bid = blockIdx.x;
  unsigned bar_target = 0;
  __shared__ uint4 xb_words;
  volatile LAS unsigned* xst = (volatile LAS unsigned*)&xb_words;
  if (threadIdx.x == 0) xst[2] = bar_add(P.bar + 64 * (2 * NG + 1 + xcc_id()));
  run_phase<0>(P, 0, smem, nb, bid, xst);
  grid.sync();
  if (threadIdx.x == 0) {
    unsigned mine = 0, cnt = 0, dense = 0; const unsigned me = xcc_id();
    for (unsigned j = 0; j < 16; ++j) { const unsigned c = bar_ld(P.bar + 64 * (2 * NG + 1 + j)); cnt += c > 0u ? 1u : 0u; dense += (j < me && c > 0u) ? 1u : 0u; mine = j == me ? c : mine; }
    xst[0] = mine; xst[1] = cnt; xst[3] = dense | (cnt == 8u ? 0x100u : 0u);
  }
  __syncthreads();
#define GSYNC() { bar_target += 1u; grp_barrier(P.bar, bar_target, xst); }
#define RUNP(k) { run_phase<k>(P, l, smem, nb, bid, xst); GSYNC(); if (DUP_MASK & (1 << k)) { run_phase<k>(P, l, smem, nb, bid, xst); GSYNC(); } }
  for (int l = 0; l < NL; ++l) {
    RUNP(1) RUNP(2) RUNP(3) RUNP(4) RUNP(5) RUNP(6) RUNP(7) RUNP(8) RUNP(9) RUNP(10)
  }
  run_phase<11>(P, 0, smem, nb, bid, xst);
}
#else
template <int PH> __global__ void __launch_bounds__(NTHR, 2) phase_kernel(Params P, int l) {
  __shared__ __attribute__((aligned(16))) char smem_raw[SMEM_BYTES];
  run_phase<PH>(P, l, (lptr)smem_raw, gridDim.x, blockIdx.x, nullptr);
}
#endif

extern "C" void kernel_launch(void* const* d_in, const int* in_sizes, int n_in, void* d_out, int out_size, void* d_ws, size_t ws_size,
                              hipStream_t stream) {
  Params P{};
  P.x = (const float*)d_in[0]; P.pos = (const int*)d_in[1];
  const float** fp = &P.mix_norm;
  for (int i = 0; i < 28; ++i) fp[i] = (const float*)d_in[2 + i];
  P.out = (float*)d_out;
  char* ws = (char*)d_ws; size_t off = 0;
  auto take = [&](size_t bytes) { char* p = ws + off; off += (bytes + 255) & ~(size_t)255; return p; };
  P.xres = (float*)take((size_t)T * D * 4);
  P.hb = (bf16_t*)take((size_t)T * D * 2);
  P.mixed = (bf16_t*)take((size_t)T * D * 2);
  P.proj = (bf16_t*)take((size_t)T * PW * 2);
  P.preA = (bf16_t*)take((size_t)T * 256 * 2);
  P.preB = (bf16_t*)take((size_t)T * 256 * 2);
  P.preC = (bf16_t*)take((size_t)T * 256 * 2);
  P.hidden = P.proj;
  P.Xc = (bf16_t*)take((size_t)T * 512 * 2);
  P.fft1 = (bf16_t*)take((size_t)2 * 128 * 128 * 256 * 2);
  P.wb = (bf16_t*)take((size_t)WB_ELEMS * 2);
  P.Qb = (bf16_t*)take((size_t)T * 4 * 96 * 2);
  P.Kb = (bf16_t*)take((size_t)T * 4 * 96 * 2);
  P.Vt = (bf16_t*)take((size_t)T * 256 * 2);
  P.LW = (bf16_t*)take((size_t)2 * T * 256 * 2);
  P.AA = (bf16_t*)take((size_t)2 * T * 256 * 2);
  P.Gg = (bf16_t*)take((size_t)T * 256 * 2);
  P.YS = (float*)take((size_t)2 * T * 256 * 4);
  P.Wf = (bf16_t*)take((size_t)NL * 512 * 1024 * 2);
  P.ropeC = (float*)take((size_t)T * 16 * 4);
  P.ropeS = (float*)take((size_t)T * 16 * 4);
  P.tabC = (bf16_t*)take(128 * 128 * 2);
  P.tabMS = (bf16_t*)take(128 * 128 * 2);
  P.tabT2 = (bf16_t*)take(128 * 128 * 2);
  P.bar = (unsigned*)take(64 * (5 * NG + 3) * 4);
  for (int i = 0; i < 16; ++i) P.invf[i] = pow(10000.0, -(double)i / 16.0);
  if (off > ws_size) { fprintf(stderr, "workspace too small: need %zu have %zu\n", off, ws_size); return; }
#if !MULTI_LAUNCH
  static int grid_blocks = 0;
  if (!grid_blocks) {
    int dev = 0, cus = 0, per_cu = 0;
    hipGetDevice(&dev);
    hipDeviceGetAttribute(&cus, hipDeviceAttributeMultiprocessorCount, dev);
    hipOccupancyMaxActiveBlocksPerMultiprocessor(&per_cu, mega_kernel, NTHR, 0);
    if (per_cu > 2) per_cu = 2;
    grid_blocks = cus * per_cu;
  }
  (void)hipMemsetAsync(P.bar, 0, 64 * (5 * NG + 3) * 4, stream);
  void* args[] = {&P};
  hipError_t e = hipLaunchCooperativeKernel((void*)mega_kernel, dim3(grid_blocks), dim3(NTHR), args, 0, stream);
  if (e != hipSuccess) fprintf(stderr, "cooperative launch failed: %s (grid %d)\n", hipGetErrorString(e), grid_blocks);
#else
  const int G = 512;
  phase_kernel<0><<<G, NTHR, 0, stream>>>(P, 0);
  for (int l = 0; l < NL; ++l) {
    phase_kernel<1><<<G, NTHR, 0, stream>>>(P, l);
    phase_kernel<2><<<G, NTHR, 0, stream>>>(P, l);
    phase_kernel<3><<<G, NTHR, 0, stream>>>(P, l);
    phase_kernel<4><<<G, NTHR, 0, stream>>>(P, l);
    phase_kernel<5><<<G, NTHR, 0, stream>>>(P, l);
    phase_kernel<6><<<G, NTHR, 0, stream>>>(P, l);
    phase_kernel<7><<<G, NTHR, 0, stream>>>(P, l);
    phase_kernel<8><<<G, NTHR, 0, stream>>>(P, l);
    phase_kernel<9><<<G, NTHR, 0, stream>>>(P, l);
    phase_kernel<10><<<G, NTHR, 0, stream>>>(P, l);
  }
  phase_kernel<11><<<G, NTHR, 0, stream>>>(P, 0);
#endif
}
```
